# Optimizing an MI355X kernel written in HIP

```python
import jax, jax.numpy as jnp
from jax import lax
import numpy as np

D_MODEL = 2048
BATCH = 8
SEQ = 4096
DEPTH = 2
DEC_BATCH = 16
DEC_SEQ = 32
PAST_LEN = 1024

CHUNK = 64
POOL_DIM = D_MODEL // 4
POOL_WINDOWS = (2, 4, 8, 16)
POOL_GROUPS = len(POOL_WINDOWS)
POOL_GROUP_DIM = POOL_DIM // POOL_GROUPS
POOL_HIST = max(POOL_WINDOWS) - 1
SGU_DIM = D_MODEL // 2
SGU_GROUPS = 8
SGU_GROUP_DIM = SGU_DIM // SGU_GROUPS
SGU_CHUNK = 128
CONV_DIM = D_MODEL // 4
CONV_WIDTH = 3
D_FF = -(-8 * D_MODEL // (3 * 256)) * 256
PLE_DIM = 256
N_BRANCH = 3
ALPHA = (2 * DEPTH) ** 0.25
BETA = (8 * DEPTH) ** -0.25
LN_EPS = 1e-5
OFF_U = POOL_DIM
OFF_V = OFF_U + SGU_DIM
OFF_CB = OFF_V + SGU_DIM
OFF_CC = OFF_CB + CONV_DIM
OFF_CX = OFF_CC + CONV_DIM
OFF_G = OFF_CX + CONV_DIM
IN_COLS = OFF_G + N_BRANCH * D_MODEL

kernel_name = 'hybrid_pool_sgu_conv_stream_step'


def layer_norm(x, g, b):
    xf = x.astype(jnp.float32)
    mu = jnp.mean(xf, axis=-1, keepdims=True)
    var = jnp.mean(jnp.square(xf - mu), axis=-1, keepdims=True)
    out = (xf - mu) * lax.rsqrt(var + LN_EPS) * g.astype(jnp.float32) + b.astype(jnp.float32)
    return out.astype(x.dtype)


def pool_mix(a, hist, pos0, pool_w, pool_scale):
    bsz, L, _ = a.shape
    xp = jnp.concatenate([hist, a], axis=1).astype(jnp.float32)
    cs = jnp.concatenate([jnp.zeros_like(xp[:, :1]), jnp.cumsum(xp, axis=1)], axis=1)
    end = cs[:, POOL_HIST + 1:]
    pos = pos0 + jnp.arange(L, dtype=jnp.int32) + 1
    outs = []
    for g, win in enumerate(POOL_WINDOWS):
        sl = slice(g * POOL_GROUP_DIM, (g + 1) * POOL_GROUP_DIM)
        start = cs[:, POOL_HIST + 1 - win:POOL_HIST + 1 - win + L, sl]
        cnt = jnp.minimum(pos, win).astype(jnp.float32)[None, :, None]
        outs.append((end[..., sl] - start) / cnt)
    pooled = (jnp.concatenate(outs, axis=-1) - a.astype(jnp.float32)).astype(a.dtype)
    pooled = pooled.reshape(bsz, L, POOL_GROUPS, POOL_GROUP_DIM)
    y = jnp.einsum('blgc,gcd->blgd', pooled, pool_w).reshape(bsz, L, POOL_DIM)
    return y * pool_scale


def spatial_gate(u, v, sgu_w, sgu_b):
    bsz, L, _ = v.shape
    lc = min(L, SGU_CHUNK)
    n = L // lc
    vr = v.reshape(bsz, n, lc, SGU_GROUPS, SGU_GROUP_DIM)
    w = jnp.tril(sgu_w[:, :lc, :lc])
    s = jnp.einsum('gts,bnsgc->bntgc', w, vr) + jnp.transpose(sgu_b[:, :lc])[None, None, :, :, None]
    return u * s.reshape(bsz, L, SGU_DIM)


def causal_conv(z, hist, conv_w):
    L = z.shape[1]
    zp = jnp.concatenate([hist, z], axis=1)
    y = zp[:, 0:L] * conv_w[0]
    for k in range(1, CONV_WIDTH):
        y = y + zp[:, k:k + L] * conv_w[k]
    return y


def trunk_layer(x, p, hist_pool, hist_conv, pos0, w_in, pool_w, pool_scale, sgu_ln_g, sgu_ln_b,
                sgu_w, sgu_b, conv_w, w_br_a, w_br_b, w_br_c, w_o, ln1_g, ln1_b, w_gu, w_down,
                w_pe, w_pe_gate, ln2_g, ln2_b):
    z = x @ w_in
    a_in = z[..., :OFF_U]
    u = jax.nn.gelu(z[..., OFF_U:OFF_V], approximate=False)
    v = layer_norm(jax.nn.gelu(z[..., OFF_V:OFF_CB], approximate=False), sgu_ln_g, sgu_ln_b)
    c_b = z[..., OFF_CB:OFF_CC]
    c_c = z[..., OFF_CC:OFF_CX]
    c_x = z[..., OFF_CX:OFF_G]
    g_a = jax.nn.sigmoid(z[..., OFF_G:OFF_G + D_MODEL])
    g_b = jax.nn.sigmoid(z[..., OFF_G + D_MODEL:OFF_G + 2 * D_MODEL])
    g_c = jax.nn.sigmoid(z[..., OFF_G + 2 * D_MODEL:])

    y_a = pool_mix(a_in, hist_pool, pos0, pool_w, pool_scale)
    y_b = spatial_gate(u, v, sgu_w, sgu_b)
    conv_in = c_c * c_x
    y_c = c_b * causal_conv(conv_in, hist_conv, conv_w)

    merged = g_a * (y_a @ w_br_a) + g_b * (y_b @ w_br_b) + g_c * (y_c @ w_br_c)
    x = layer_norm(ALPHA * x + merged @ w_o, ln1_g, ln1_b)

    h = x @ w_gu
    ffn = (jax.nn.silu(h[..., :D_FF]) * h[..., D_FF:]) @ w_down
    ple = jax.nn.sigmoid(x @ w_pe_gate) * (p @ w_pe)
    x = layer_norm(ALPHA * x + ffn + ple, ln2_g, ln2_b)

    new_pool = jnp.concatenate([hist_pool, a_in], axis=1)[:, -POOL_HIST:]
    new_conv = jnp.concatenate([hist_conv, conv_in], axis=1)[:, -(CONV_WIDTH - 1):]
    return x, new_pool, new_conv, v


def setup_inputs(seed: int = 0) -> dict:
    key = jax.random.key(seed)
    ks = jax.random.split(key, 32)

    def nrm(k, shape, scale=1.0):
        return jax.random.normal(k, shape, jnp.float32) * scale

    D = D_MODEL
    return {
        'x_prompt': nrm(ks[0], (BATCH, SEQ, D)),
        'x_sample': nrm(ks[1], (DEC_BATCH, DEC_SEQ, D)),
        'state_pool': nrm(ks[2], (DEPTH, DEC_BATCH, POOL_HIST, POOL_DIM)),
        'state_conv': nrm(ks[3], (DEPTH, DEC_BATCH, CONV_WIDTH - 1, CONV_DIM)),
        'p_prompt': nrm(ks[4], (DEPTH, BATCH, SEQ, PLE_DIM)),
        'p_sample': nrm(ks[5], (DEPTH, DEC_BATCH, DEC_SEQ, PLE_DIM)),
        'w_in': nrm(ks[6], (DEPTH, D, IN_COLS), D ** -0.5),
        'pool_w': nrm(ks[7], (DEPTH, POOL_GROUPS, POOL_GROUP_DIM, POOL_GROUP_DIM), POOL_GROUP_DIM ** -0.5),
        'pool_scale': 1.0 + nrm(ks[8], (DEPTH, POOL_DIM), 0.1),
        'sgu_ln_g': 1.0 + nrm(ks[9], (DEPTH, SGU_DIM), 0.01),
        'sgu_ln_b': nrm(ks[10], (DEPTH, SGU_DIM), 0.01),
        'sgu_w': nrm(ks[11], (DEPTH, SGU_GROUPS, SGU_CHUNK, SGU_CHUNK), SGU_CHUNK ** -0.5),
        'sgu_b': 1.0 + nrm(ks[12], (DEPTH, SGU_GROUPS, SGU_CHUNK), 0.1),
        'conv_w': nrm(ks[13], (DEPTH, CONV_WIDTH, CONV_DIM), CONV_WIDTH ** -0.5),
        'w_br_a': nrm(ks[14], (DEPTH, POOL_DIM, D), POOL_DIM ** -0.5),
        'w_br_b': nrm(ks[15], (DEPTH, SGU_DIM, D), SGU_DIM ** -0.5),
        'w_br_c': nrm(ks[16], (DEPTH, CONV_DIM, D), CONV_DIM ** -0.5),
        'w_o': nrm(ks[17], (DEPTH, D, D), BETA * D ** -0.5),
        'ln1_g': 1.0 + nrm(ks[18], (DEPTH, D), 0.01),
        'ln1_b': nrm(ks[19], (DEPTH, D), 0.01),
        'w_gu': nrm(ks[20], (DEPTH, D, 2 * D_FF), D ** -0.5),
        'w_down': nrm(ks[21], (DEPTH, D_FF, D), BETA * D_FF ** -0.5),
        'w_pe': nrm(ks[22], (DEPTH, PLE_DIM, D), BETA * PLE_DIM ** -0.5),
        'w_pe_gate': nrm(ks[23], (DEPTH, D, D), D ** -0.5),
        'ln2_g': 1.0 + nrm(ks[24], (DEPTH, D), 0.01),
        'ln2_b': nrm(ks[25], (DEPTH, D), 0.01),
    }


def reference(x_prompt, x_sample, state_pool, state_conv, p_prompt, p_sample, w_in, pool_w,
              pool_scale, sgu_ln_g, sgu_ln_b, sgu_w, sgu_b, conv_w, w_br_a, w_br_b, w_br_c, w_o,
              ln1_g, ln1_b, w_gu, w_down, w_pe, w_pe_gate, ln2_g, ln2_b):
    yp = x_prompt
    ys = x_sample
    zero_pool = jnp.zeros((x_prompt.shape[0], POOL_HIST, POOL_DIM), x_prompt.dtype)
    zero_conv = jnp.zeros((x_prompt.shape[0], CONV_WIDTH - 1, CONV_DIM), x_prompt.dtype)
    pool_p, conv_p, pool_s, conv_s, sgu_v_s = [], [], [], [], []
    for i in range(DEPTH):
        lw = (w_in[i], pool_w[i], pool_scale[i], sgu_ln_g[i], sgu_ln_b[i], sgu_w[i], sgu_b[i],
              conv_w[i], w_br_a[i], w_br_b[i], w_br_c[i], w_o[i], ln1_g[i], ln1_b[i], w_gu[i],
              w_down[i], w_pe[i], w_pe_gate[i], ln2_g[i], ln2_b[i])
        yp, np_pool, np_conv, _ = trunk_layer(yp, p_prompt[i], zero_pool, zero_conv, 0, *lw)
        ys, ns_pool, ns_conv, ns_v = trunk_layer(ys, p_sample[i], state_pool[i], state_conv[i],
                                                 PAST_LEN, *lw)
        pool_p.append(np_pool)
        conv_p.append(np_conv)
        pool_s.append(ns_pool)
        conv_s.append(ns_conv)
        sgu_v_s.append(ns_v)
    return (yp, ys, jnp.stack(pool_p), jnp.stack(conv_p), jnp.stack(pool_s), jnp.stack(conv_s),
            jnp.stack(sgu_v_s))
```

```cpp
#include <hip/hip_runtime.h>
#include <hip/hip_cooperative_groups.h>
#include <cstdio>
#include <cstdint>
namespace cg = cooperative_groups;

#define LAS __attribute__((address_space(3)))
typedef unsigned short bf16_t;
typedef short bf16x8 __attribute__((ext_vector_type(8)));
typedef float f32x4 __attribute__((ext_vector_type(4)));
typedef float f32x2 __attribute__((ext_vector_type(2)));
typedef unsigned u32x4 __attribute__((ext_vector_type(4)));
typedef unsigned u32x2 __attribute__((ext_vector_type(2)));

constexpr int DM = 2048, MP = 32768, MS = 512, MT = MP + MS;
constexpr int NIN = 10240, NZ = 4096, NGT = 6144, DFF = 5632, PLE = 256, NGU = 2 * DFF + DM;
constexpr float LN_EPS = 1e-5f, ALPHA = 1.41421356237f;
constexpr size_t O_YS = 67108864, O_NPP = O_YS + 1048576, O_NCP = O_NPP + 122880, O_NPS = O_NCP + 16384, O_NCS = O_NPS + 245760, O_SGV = O_NCS + 32768;
constexpr size_t MiB = 1u << 20;
constexpr int LD_ACT = DFF + 128;
constexpr size_t WS_WIN = 1 * MiB, WS_WBR = 41 * MiB, WS_WO = 49 * MiB, WS_WGU = 57 * MiB, WS_WDN = 109 * MiB, WS_WPE = 132 * MiB, WS_SGW = 133 * MiB;
constexpr size_t WS_PB0 = 134 * MiB, WS_PB1 = 150 * MiB + 512 * 1024;
static_assert(WS_WDN + (size_t)DM * LD_ACT * 2 <= WS_WPE && WS_PB0 + (size_t)MT * PLE * 2 <= WS_PB1 && WS_PB1 + (size_t)MT * PLE * 2 <= 167 * MiB, "ws map");
constexpr size_t WS_Z = 167 * MiB, WS_G = 427 * MiB, WS_Y = 817 * MiB;
constexpr size_t WS_T = 167 * MiB, WS_X1 = 297 * MiB, WS_ACT = 427 * MiB, WS_PE = 793 * MiB, WS_PART = 947 * MiB, WS_END = 979 * MiB;
static_assert(WS_ACT + (size_t)MT * LD_ACT * 2 <= WS_PE && WS_PE + (size_t)MT * DM * 2 <= WS_END, "ws map 2");
constexpr size_t DO_XB = 0, DO_MG = 130 * MiB;
constexpr int LDS_BYTES = 147456;

__device__ __forceinline__ unsigned cvt_pk_bf16(float lo, float hi) { unsigned r; asm volatile("v_cvt_pk_bf16_f32 %0, %1, %2" : "=v"(r) : "v"(lo), "v"(hi)); return r; }
__device__ __forceinline__ float bflo(unsigned w) { return __uint_as_float(w << 16); }
__device__ __forceinline__ float bfhi(unsigned w) { return __uint_as_float(w & 0xffff0000u); }
__device__ __forceinline__ float bf2f(bf16_t h) { return __uint_as_float(((unsigned)h) << 16); }
__device__ __forceinline__ float sigmoidf_(float x) { return __builtin_amdgcn_rcpf(1.0f + __builtin_amdgcn_exp2f(-1.44269504089f * x)); }
__device__ __forceinline__ float wave_sum(float v) {
#pragma unroll
    for (int o = 1; o < 64; o <<= 1) v += __shfl_xor(v, o);
    return v;
}
__device__ __forceinline__ f32x2 gelu_pk(f32x2 v) {
    const f32x2 av = __builtin_elementwise_abs(v), d = av * 0.2316418882f + 1.0f;
    f32x2 t; t.x = __builtin_amdgcn_rcpf(d.x); t.y = __builtin_amdgcn_rcpf(d.y);
    f32x2 q = t * 0.5307027145f + (-0.7265760135f); q = q * t + 0.7107068705f; q = q * t + (-0.142248368f); q = q * t + 0.127414796f; q = q * t;
    const f32x2 s = (v * v) * (-0.72134752044f);
    f32x2 e; e.x = __builtin_amdgcn_exp2f(s.x); e.y = __builtin_amdgcn_exp2f(s.y);
    const f32x2 m = v * (q * e), r = v - m;
    f32x2 o; o.x = v.x < 0.f ? m.x : r.x; o.y = v.y < 0.f ? m.y : r.y; return o;
}
__device__ __forceinline__ char* uptr(const void* p) { const unsigned long long v = (unsigned long long)p; const unsigned lo = __builtin_amdgcn_readfirstlane((unsigned)v), hi = __builtin_amdgcn_readfirstlane((unsigned)(v >> 32)); return (char*)(((unsigned long long)hi << 32) | lo); }
__device__ __forceinline__ void unpack8(const u32x4 v, float (&f)[8]) { f[0] = bflo(v.x); f[1] = bfhi(v.x); f[2] = bflo(v.y); f[3] = bfhi(v.y); f[4] = bflo(v.z); f[5] = bfhi(v.z); f[6] = bflo(v.w); f[7] = bfhi(v.w); }

namespace pg8 {
constexpr int BM = 256, BK = 64, HALF = 128, HTB = HALF * BK * 2, STAGE_BYTES = 8 * HTB, NXCD = 8, WGM = 4;
__device__ __forceinline__ int lds_byte(int r, int c) { const int st = (r >> 4) * 2 + (c >> 5), rr = r & 15, cc = c & 31, ob = rr * 64 + cc * 2; return st * 1024 + (ob ^ (((ob >> 9) & 1) << 5)); }
__device__ __forceinline__ void stage_rc(int b, int& R, int& C) { const int st = b / 1024, sb = b % 1024, swz = sb ^ (((sb >> 9) & 1) << 5); R = (st >> 1) * 16 + swz / 64; C = (st & 1) * 32 + (swz % 64) / 2; }
__device__ __forceinline__ int perm32(int rho) { const int n = rho >> 4, i = rho & 15; return 8 * (i >> 2) + 4 * n + (i & 3); }

struct Unit { int pm, pn, seg, part; };
struct Gemm { const bf16_t* A; const bf16_t* Bt; int ld; int nseg; unsigned ntpack, kopack; int nts; };
__device__ __forceinline__ unsigned pack3(int a, int b, int c) { return (unsigned)a | ((unsigned)b << 8) | ((unsigned)c << 16); }
__device__ __forceinline__ int seg_nt(const Gemm& g, int s) { return (int)((g.ntpack >> (8 * s)) & 0xffu); }
__device__ __forceinline__ int unit_nt(const Gemm& g, const Unit& u) { return u.part ? g.nts : seg_nt(g, u.seg); }
__device__ __forceinline__ int seg_koff(const Gemm& g, int s) { return BK * (int)((g.kopack >> (8 * s)) & 0xffu); }
__device__ __forceinline__ int unit_koff(const Gemm& g, const Unit& u) { return u.part ? BK * u.seg * g.nts : seg_koff(g, u.seg); }

struct Order {
    int nM, nN, nwg, G, c, nseg;
    int nsl, nslu, pm_sl;
    __device__ __forceinline__ void init(int nM_, int nN_, int G_, int c_, int nseg_) { nM = nM_; nN = nN_; nwg = nM * nN; G = G_; c = c_; nseg = nseg_; nsl = 1; nslu = 0; pm_sl = 0; }
    __device__ __forceinline__ void slices(int pm0, int ntiles_m, int nsl_) { pm_sl = pm0; nsl = nsl_; nslu = ntiles_m * nN * nsl_; }
    __device__ __forceinline__ bool next(int i, Unit& u) const {
        const int it = (nseg == 1) ? i : i / nseg; u.seg = i - it * nseg; u.part = 0;
        const long L = (long)it * G + c;
        if (L >= nwg) { const long s = L - nwg; if (s >= nslu) return false;
            const int tile = (int)s / nsl; u.seg = (int)s - tile * nsl; u.part = 1; u.pm = pm_sl + tile / nN; u.pn = tile % nN; return true; }
        int wgid = (int)L; { const int q = nwg / NXCD, r = nwg % NXCD, xcd = wgid % NXCD, off = wgid / NXCD; wgid = (xcd < r ? xcd * (q + 1) : r * (q + 1) + (xcd - r) * q) + off; }
        const int nig = WGM * nN, gid = wgid / nig, fm = gid * WGM, gsz = (nM - fm) < WGM ? (nM - fm) : WGM;
        u.pm = fm + ((wgid % nig) % gsz); u.pn = (wgid % nig) / gsz; return true;
    }
};

template <class Epi, bool ALIGN_EPI, bool SP2>
__device__ __forceinline__ void gemm_phase(LAS unsigned char* lds, const Gemm g, const Order& S, const Epi& E, const int tid) {
    const int wid = __builtin_amdgcn_readfirstlane(tid >> 6), lane = tid & 63, wr = wid >> 2, wc = wid & 3, fr = lane & 15, fq = lane >> 4;
    const int ld = g.ld;
    unsigned voffA[2], voffB[2];
#pragma unroll
    for (int i = 0; i < 2; ++i) { int R, C; stage_rc(tid * 16 + i * 8192, R, C); const int Rb = (R & ~31) + perm32(R & 31);
        voffA[i] = (unsigned)(R * ld + C) * 2u; voffB[i] = (unsigned)(Rb * ld + C) * 2u; }
    const size_t kstep = (size_t)(BK * 2);
    const size_t hstep = (size_t)HALF * ld * 2;
    const size_t tstep = 2 * hstep;
    const unsigned ldsw = (unsigned)wid * 1024u;
    const int aoff = lds_byte(wr * 64 + fr, fq * 8), boff = lds_byte(wc * 32 + fr, fq * 8);
#define PG8_SA(b, h) (((b) * 2 + (h)) * HTB)
#define PG8_SB(b, h) ((4 + (b) * 2 + (h)) * HTB)
#define PG8_STAGE(bufoff, gbase, voff) do { _Pragma("unroll") for (int _i = 0; _i < 2; ++_i) \
        __builtin_amdgcn_global_load_lds((const unsigned*)((const char*)(gbase) + (voff)[_i]), (LAS unsigned*)(lds + (bufoff) + ldsw + _i * 8192), 16, 0, 0); } while (0)
#define PG8_LDA(dst, b, h) do { _Pragma("unroll") for (int m = 0; m < 4; ++m) _Pragma("unroll") for (int k = 0; k < 2; ++k) dst[m][k] = *(const LAS bf16x8*)(lds + PG8_SA(b, h) + aoff + m * 2048 + k * 1024); } while (0)
#define PG8_LDB(dst, b, h) do { _Pragma("unroll") for (int n = 0; n < 2; ++n) _Pragma("unroll") for (int k = 0; k < 2; ++k) dst[n][k] = *(const LAS bf16x8*)(lds + PG8_SB(b, h) + boff + n * 2048 + k * 1024); } while (0)
#define PG8_MMA(ai, bj, At, Bt) do { __builtin_amdgcn_s_setprio(1); _Pragma("unroll") for (int m = 0; m < 4; ++m) _Pragma("unroll") for (int n = 0; n < 2; ++n) _Pragma("unroll") for (int k = 0; k < 2; ++k) \
        acc[ai][bj][m][n] = __builtin_amdgcn_mfma_f32_16x16x32_bf16(Bt[n][k], At[m][k], acc[ai][bj][m][n], 0, 0, 0); __builtin_amdgcn_s_setprio(0); } while (0)
#define PG8_WAIT_V(n) asm volatile("s_waitcnt vmcnt(" #n ")" ::: "memory")
#define PG8_WAIT_L(n) asm volatile("s_waitcnt lgkmcnt(" #n ")" ::: "memory")
#define PG8_BAR __builtin_amdgcn_s_barrier()
#define PG8_SCHED __builtin_amdgcn_sched_barrier(0)
    Unit cur, nxt; int ui = 0;
    if (!S.next(0, cur)) return;
    f32x4 acc[2][2][4][2];
#pragma unroll
    for (int a = 0; a < 2; ++a)
#pragma unroll
        for (int b = 0; b < 2; ++b)
#pragma unroll
            for (int m = 0; m < 4; ++m)
#pragma unroll
                for (int n = 0; n < 2; ++n) acc[a][b][m][n] = (f32x4){0.f, 0.f, 0.f, 0.f};
    bf16x8 At[4][2], B0[2][2], B1[2][2];
    int nt = unit_nt(g, cur);
    const char* cA = (const char*)g.A + (size_t)cur.pm * tstep + (size_t)unit_koff(g, cur) * 2; const char* cB = (const char*)g.Bt + (size_t)cur.pn * tstep + (size_t)unit_koff(g, cur) * 2;
    if constexpr (SP2) {
        PG8_STAGE(PG8_SB(0, 0), cB, voffB); PG8_STAGE(PG8_SB(0, 1), cB + hstep, voffB); PG8_STAGE(PG8_SA(0, 0), cA, voffA); PG8_STAGE(PG8_SA(0, 1), cA + hstep, voffA);
        if (wr == 1) PG8_BAR;
        PG8_WAIT_V(2); PG8_BAR;
        PG8_STAGE(PG8_SB(1, 0), cB + kstep, voffB); PG8_STAGE(PG8_SA(1, 0), cA + kstep, voffA); PG8_STAGE(PG8_SB(1, 1), cB + hstep + kstep, voffB);
        PG8_WAIT_V(6); PG8_BAR;
    } else {
        PG8_STAGE(PG8_SB(0, 0), cB, voffB); PG8_STAGE(PG8_SA(0, 0), cA, voffA); PG8_STAGE(PG8_SB(0, 1), cB + hstep, voffB); PG8_STAGE(PG8_SA(0, 1), cA + hstep, voffA);
        if (wr == 1) PG8_BAR;
        PG8_WAIT_V(4); PG8_BAR;
        PG8_STAGE(PG8_SB(1, 0), cB + kstep, voffB); PG8_STAGE(PG8_SA(1, 0), cA + kstep, voffA); PG8_STAGE(PG8_SB(1, 1), cB + hstep + kstep, voffB);
        PG8_WAIT_V(6); PG8_BAR;
    }
    for (;;) {
        const bool has_next = S.next(ui + 1, nxt);
        const char* nA = has_next ? (const char*)g.A + (size_t)nxt.pm * tstep + (size_t)unit_koff(g, nxt) * 2 : cA;
        const char* nB = has_next ? (const char*)g.Bt + (size_t)nxt.pn * tstep + (size_t)unit_koff(g, nxt) * 2 : cB;
        for (int t = 0; t < nt; t += 2) {
            const bool last = (t == nt - 2);
            const char* a1 = cA + (size_t)(t + 1) * kstep;
            const char* a2 = last ? nA : cA + (size_t)(t + 2) * kstep; const char* b2 = last ? nB : cB + (size_t)(t + 2) * kstep;
            const char* a3 = a2 + kstep; const char* b3 = b2 + kstep;
            if constexpr (SP2) {
            PG8_LDB(B0, 0, 0); PG8_LDB(B1, 0, 1); PG8_SCHED; PG8_LDA(At, 0, 0); PG8_STAGE(PG8_SA(1, 1), a1 + hstep, voffA);
            PG8_WAIT_V(8); PG8_WAIT_L(0); PG8_BAR; PG8_MMA(0, 0, At, B0); PG8_MMA(0, 1, At, B1); PG8_BAR; PG8_SCHED;
            PG8_LDA(At, 0, 1); PG8_STAGE(PG8_SB(0, 0), b2, voffB); PG8_STAGE(PG8_SB(0, 1), b2 + hstep, voffB); PG8_STAGE(PG8_SA(0, 0), a2, voffA);
            PG8_WAIT_V(8); PG8_WAIT_L(0); PG8_BAR; PG8_MMA(1, 0, At, B0); PG8_MMA(1, 1, At, B1); PG8_BAR; PG8_SCHED;
            PG8_LDB(B0, 1, 0); PG8_LDB(B1, 1, 1); PG8_SCHED; PG8_LDA(At, 1, 0); PG8_STAGE(PG8_SA(0, 1), a2 + hstep, voffA);
            PG8_WAIT_V(8); PG8_WAIT_L(0); PG8_BAR; PG8_MMA(0, 0, At, B0); PG8_MMA(0, 1, At, B1); PG8_BAR; PG8_SCHED;
            PG8_LDA(At, 1, 1); PG8_STAGE(PG8_SB(1, 0), b3, voffB); PG8_STAGE(PG8_SB(1, 1), b3 + hstep, voffB); PG8_STAGE(PG8_SA(1, 0), a3, voffA);
            PG8_WAIT_V(8); PG8_WAIT_L(0); PG8_BAR; PG8_MMA(1, 0, At, B0); PG8_MMA(1, 1, At, B1); PG8_BAR; PG8_SCHED;
            } else {
            PG8_LDB(B0, 0, 0); PG8_SCHED; PG8_LDA(At, 0, 0); PG8_STAGE(PG8_SA(1, 1), a1 + hstep, voffA);
            PG8_WAIT_L(8); PG8_BAR; PG8_WAIT_L(0); PG8_MMA(0, 0, At, B0); PG8_BAR; PG8_SCHED;
            PG8_LDB(B1, 0, 1); PG8_STAGE(PG8_SB(0, 0), b2, voffB);
            PG8_BAR; PG8_WAIT_L(0); PG8_MMA(0, 1, At, B1); PG8_BAR;
            PG8_LDA(At, 0, 1); PG8_STAGE(PG8_SA(0, 0), a2, voffA);
            PG8_BAR; PG8_WAIT_L(0); PG8_MMA(1, 0, At, B0); PG8_BAR; PG8_SCHED;
            PG8_STAGE(PG8_SB(0, 1), b2 + hstep, voffB);
            PG8_WAIT_V(6); PG8_BAR; PG8_MMA(1, 1, At, B1); PG8_BAR;
            PG8_LDB(B0, 1, 0); PG8_SCHED; PG8_LDA(At, 1, 0); PG8_STAGE(PG8_SA(0, 1), a2 + hstep, voffA);
            PG8_WAIT_L(8); PG8_BAR; PG8_WAIT_L(0); PG8_MMA(0, 0, At, B0); PG8_BAR; PG8_SCHED;
            PG8_LDB(B1, 1, 1); PG8_STAGE(PG8_SB(1, 0), b3, voffB);
            PG8_BAR; PG8_WAIT_L(0); PG8_MMA(0, 1, At, B1); PG8_BAR;
            PG8_LDA(At, 1, 1); PG8_STAGE(PG8_SA(1, 0), a3, voffA);
            PG8_BAR; PG8_WAIT_L(0); PG8_MMA(1, 0, At, B0); PG8_BAR; PG8_SCHED;
            PG8_STAGE(PG8_SB(1, 1), b3 + hstep, voffB);
            PG8_WAIT_V(6); PG8_BAR; PG8_MMA(1, 1, At, B1); PG8_BAR;
            }
        }
        if constexpr (ALIGN_EPI) { if (wr == 0) PG8_BAR; }
        const bool keep = E(acc, cur, wr, wc, fr, fq);
        if (!has_next) break;
        if (!keep) {
#pragma unroll
        for (int a = 0; a < 2; ++a)
#pragma unroll
            for (int b = 0; b < 2; ++b)
#pragma unroll
                for (int m = 0; m < 4; ++m)
#pragma unroll
                    for (int n = 0; n < 2; ++n) acc[a][b][m][n] = (f32x4){0.f, 0.f, 0.f, 0.f};
        }
        cur = nxt; cA = nA; cB = nB; nt = unit_nt(g, cur); ++ui;
        if constexpr (ALIGN_EPI) { if (wr == 1) PG8_BAR; }
    }
    PG8_WAIT_V(0);
    if constexpr (!ALIGN_EPI) { if (wr == 0) PG8_BAR; }
    PG8_BAR;
#undef PG8_SA
#undef PG8_SB
#undef PG8_STAGE
#undef PG8_LDA
#undef PG8_LDB
#undef PG8_MMA
#undef PG8_WAIT_V
#undef PG8_WAIT_L
#undef PG8_BAR
#undef PG8_SCHED
}

typedef f32x4 AccT[2][2][4][2];
#define EPI_ROWS_BEGIN _Pragma("unroll") for (int ai = 0; ai < 2; ++ai) _Pragma("unroll") for (int m = 0; m < 4; ++m) { const int row = row0 + ai * HALF + m * 16;
#define EPI_ROWS_END asm volatile("" ::: "memory"); }
__device__ __forceinline__ u32x4 pack8(const f32x4 v0, const f32x4 v1) { u32x4 w; w.x = cvt_pk_bf16(v0[0], v0[1]); w.y = cvt_pk_bf16(v0[2], v0[3]); w.z = cvt_pk_bf16(v1[0], v1[1]); w.w = cvt_pk_bf16(v1[2], v1[3]); return w; }

struct EpiIn {
    bf16_t* Z; bf16_t* G;
    __device__ __forceinline__ bool operator()(AccT& acc, const Unit& u, int wr, int wc, int fr, int fq) const {
        bf16_t* base; int ldc, colt, mode;
        if (u.pn < 16) { base = Z; ldc = NZ; colt = u.pn * BM; mode = (u.pn >= 2 && u.pn < 10) ? 1 : 0; } else { base = G; ldc = NGT; colt = (u.pn - 16) * BM; mode = 2; }
        const int row0 = u.pm * BM + wr * 64 + fr, col0 = colt + wc * 32 + 8 * fq;
        EPI_ROWS_BEGIN
            bf16_t* rowp = base + (size_t)row * ldc + col0;
#pragma unroll
            for (int bj = 0; bj < 2; ++bj) { f32x4 v0 = acc[ai][bj][m][0], v1 = acc[ai][bj][m][1];
                if (mode == 1) { f32x2 a = gelu_pk((f32x2){v0[0], v0[1]}), b = gelu_pk((f32x2){v0[2], v0[3]}), c = gelu_pk((f32x2){v1[0], v1[1]}), d = gelu_pk((f32x2){v1[2], v1[3]});
                    v0 = (f32x4){a.x, a.y, b.x, b.y}; v1 = (f32x4){c.x, c.y, d.x, d.y}; }
                else if (mode == 2) {
#pragma unroll
                    for (int j = 0; j < 4; ++j) { v0[j] = fminf(1.0f + __builtin_amdgcn_exp2f(-1.44269504089f * v0[j]), 1e30f); v1[j] = fminf(1.0f + __builtin_amdgcn_exp2f(-1.44269504089f * v1[j]), 1e30f); } }
                *(u32x4*)(rowp + bj * HALF) = pack8(v0, v1); }
        EPI_ROWS_END
        return false;
    }
};
struct EpiStore {
    bf16_t* O; int ldc;
    __device__ __forceinline__ bool operator()(AccT& acc, const Unit& u, int wr, int wc, int fr, int fq) const {
        const int row0 = u.pm * BM + wr * 64 + fr, col0 = u.pn * BM + wc * 32 + 8 * fq;
        EPI_ROWS_BEGIN
            bf16_t* rowp = O + (size_t)row * ldc + col0;
#pragma unroll
            for (int bj = 0; bj < 2; ++bj) *(u32x4*)(rowp + bj * HALF) = pack8(acc[ai][bj][m][0], acc[ai][bj][m][1]);
        EPI_ROWS_END
        return false;
    }
};
struct EpiBr {
    const bf16_t* G; bf16_t* MG;
    __device__ __forceinline__ bool operator()(AccT& acc, const Unit& u, int wr, int wc, int fr, int fq) const {
        const int row0 = u.pm * BM + wr * 64 + fr, col0 = u.pn * BM + wc * 32 + 8 * fq;
        if (u.seg < 2) {
#pragma unroll
            for (int ai = 0; ai < 2; ++ai) {
                u32x4 wa[4][2], wb[4][2];
#pragma unroll
                for (int m = 0; m < 4; ++m) { const bf16_t* gp = G + (size_t)(row0 + ai * HALF + m * 16) * NGT + u.seg * DM + col0;
#pragma unroll
                    for (int bj = 0; bj < 2; ++bj) { wa[m][bj] = *(const u32x4*)(gp + bj * HALF); wb[m][bj] = *(const u32x4*)(gp + DM + bj * HALF); } }
#pragma unroll
                for (int m = 0; m < 4; ++m)
#pragma unroll
                    for (int bj = 0; bj < 2; ++bj) { float fa[8], fb[8]; unpack8(wa[m][bj], fa); unpack8(wb[m][bj], fb);
#pragma unroll
                        for (int j = 0; j < 4; ++j) { acc[ai][bj][m][0][j] *= fb[j] * __builtin_amdgcn_rcpf(fa[j]); acc[ai][bj][m][1][j] *= fb[4 + j] * __builtin_amdgcn_rcpf(fa[4 + j]); } }
                asm volatile("" ::: "memory");
            }
            return true;
        }
#pragma unroll
        for (int ai = 0; ai < 2; ++ai) {
            u32x4 wa[4][2];
#pragma unroll
            for (int m = 0; m < 4; ++m) { const bf16_t* gp = G + (size_t)(row0 + ai * HALF + m * 16) * NGT + 2 * DM + col0;
#pragma unroll
                for (int bj = 0; bj < 2; ++bj) wa[m][bj] = *(const u32x4*)(gp + bj * HALF); }
#pragma unroll
            for (int m = 0; m < 4; ++m) { bf16_t* op = MG + (size_t)(row0 + ai * HALF + m * 16) * DM + col0;
#pragma unroll
                for (int bj = 0; bj < 2; ++bj) { float fa[8]; unpack8(wa[m][bj], fa);
                    f32x4 v0 = acc[ai][bj][m][0], v1 = acc[ai][bj][m][1];
#pragma unroll
                    for (int j = 0; j < 4; ++j) { v0[j] *= __builtin_amdgcn_rcpf(fa[j]); v1[j] *= __builtin_amdgcn_rcpf(fa[4 + j]); }
                    *(u32x4*)(op + bj * HALF) = pack8(v0, v1); } }
            asm volatile("" ::: "memory");
        }
        return false;
    }
};
struct EpiRes {
    const bf16_t* R; const bf16_t* P; bf16_t* T; bf16_t* PART;
    __device__ __forceinline__ bool operator()(AccT& acc, const Unit& u, int wr, int wc, int fr, int fq) const {
        const int row0 = u.pm * BM + wr * 64 + fr, col0 = u.pn * BM + wc * 32 + 8 * fq;
        if (u.part) {
            EPI_ROWS_BEGIN
                bf16_t* pp = PART + ((size_t)u.seg * MS + (row - MP)) * DM + col0;
#pragma unroll
                for (int bj = 0; bj < 2; ++bj) *(u32x4*)(pp + bj * HALF) = pack8(acc[ai][bj][m][0], acc[ai][bj][m][1]);
            EPI_ROWS_END
            return false;
        }
#pragma unroll
        for (int ai = 0; ai < 2; ++ai) {
            u32x4 wrr[4][2], wpp[4][2];
#pragma unroll
            for (int m = 0; m < 4; ++m) { const size_t off = (size_t)(row0 + ai * HALF + m * 16) * DM + col0;
#pragma unroll
                for (int bj = 0; bj < 2; ++bj) { wrr[m][bj] = *(const u32x4*)(R + off + bj * HALF); if (P) wpp[m][bj] = *(const u32x4*)(P + off + bj * HALF); } }
#pragma unroll
            for (int m = 0; m < 4; ++m) { const size_t off = (size_t)(row0 + ai * HALF + m * 16) * DM + col0;
#pragma unroll
                for (int bj = 0; bj < 2; ++bj) { float fr_[8]; unpack8(wrr[m][bj], fr_);
                    f32x4 v0 = acc[ai][bj][m][0], v1 = acc[ai][bj][m][1];
#pragma unroll
                    for (int j = 0; j < 4; ++j) { v0[j] += ALPHA * fr_[j]; v1[j] += ALPHA * fr_[4 + j]; }
                    if (P) { float fp[8]; unpack8(wpp[m][bj], fp);
#pragma unroll
                        for (int j = 0; j < 4; ++j) { v0[j] += fp[j]; v1[j] += fp[4 + j]; } }
                    *(u32x4*)(T + off + bj * HALF) = pack8(v0, v1); } }
            asm volatile("" ::: "memory");
        }
        return false;
    }
};
struct EpiGu {
    bf16_t* ACT; bf16_t* PE;
    __device__ __forceinline__ bool operator()(AccT& acc, const Unit& u, int wr, int wc, int fr, int fq) const {
        const int row0 = u.pm * BM + wr * 64 + fr;
        if (u.pn < 44) {
            const int col0 = u.pn * HALF + wc * 32 + 8 * fq;
            EPI_ROWS_BEGIN
                f32x4 v0, v1;
#pragma unroll
                for (int j = 0; j < 4; ++j) { const float g0 = acc[ai][0][m][0][j], g1 = acc[ai][0][m][1][j];
                    v0[j] = g0 * sigmoidf_(g0) * acc[ai][1][m][0][j]; v1[j] = g1 * sigmoidf_(g1) * acc[ai][1][m][1][j]; }
                *(u32x4*)(ACT + (size_t)row * LD_ACT + col0) = pack8(v0, v1);
            EPI_ROWS_END
        } else {
            const int col0 = (u.pn - 44) * BM + wc * 32 + 8 * fq;
#pragma unroll
            for (int ai = 0; ai < 2; ++ai) {
                u32x4 wpp[4][2];
#pragma unroll
                for (int m = 0; m < 4; ++m) { const bf16_t* pp = PE + (size_t)(row0 + ai * HALF + m * 16) * DM + col0;
#pragma unroll
                    for (int bj = 0; bj < 2; ++bj) wpp[m][bj] = *(const u32x4*)(pp + bj * HALF); }
#pragma unroll
                for (int m = 0; m < 4; ++m) { bf16_t* pp = PE + (size_t)(row0 + ai * HALF + m * 16) * DM + col0;
#pragma unroll
                    for (int bj = 0; bj < 2; ++bj) { float fp[8]; unpack8(wpp[m][bj], fp);
                        f32x4 v0, v1;
#pragma unroll
                        for (int j = 0; j < 4; ++j) { v0[j] = sigmoidf_(acc[ai][bj][m][0][j]) * fp[j]; v1[j] = sigmoidf_(acc[ai][bj][m][1][j]) * fp[4 + j]; }
                        *(u32x4*)(pp + bj * HALF) = pack8(v0, v1); } }
                asm volatile("" ::: "memory");
            }
        }
        return false;
    }
};
}


#define XB_TMO      128
#define XB_XCNT(j)  (256  + 64 * (j))
#define XB_XSUB(j)  (1280 + 64 * (j))
#define XB_XGEN(j)  (2304 + 64 * (j))
#define XB_TOP      3328
#define XB_TOPGEN   3392
#define XCD_BAR_WORDS 3456
#define XB_SPIN_CAP (1u << 20)
__device__ __forceinline__ unsigned xb_ld(unsigned* p)              { return __hip_atomic_load(p, __ATOMIC_RELAXED, __HIP_MEMORY_SCOPE_AGENT); }
__device__ __forceinline__ unsigned xb_add(unsigned* p, unsigned v) { return __hip_atomic_fetch_add(p, v, __ATOMIC_RELAXED, __HIP_MEMORY_SCOPE_AGENT); }
__device__ __forceinline__ unsigned xb_xcc_id() { return (unsigned)__builtin_amdgcn_s_getreg((3 << 11) | 20) & 0xFu; }
#define XB_SPIN(cond, bar) do { unsigned _sp = 0; while (cond) { __builtin_amdgcn_s_sleep(1); \
    if ((++_sp & 255u) == 0u) { if (xb_ld(&(bar)[XB_TMO])) break; if (_sp > XB_SPIN_CAP) { atomicAdd(&(bar)[XB_TMO], 1u); break; } } } } while (0)
struct XcdBarrier { unsigned* bar; unsigned x; volatile LAS unsigned* st; };
__device__ __forceinline__ XcdBarrier xcd_barrier_post(unsigned* bar, volatile LAS unsigned* st) {
    XcdBarrier b; b.bar = bar; b.x = xb_xcc_id(); b.st = st;
    if (threadIdx.x == 0) (void)xb_add(&bar[XB_XCNT(b.x)], 1u);
    return b;
}
__device__ __forceinline__ void xcd_barrier_complete(unsigned* bar, unsigned x, unsigned& nloc, unsigned& nx) {
    const unsigned G = gridDim.x * gridDim.y * gridDim.z;
    unsigned sum, cnt, mine, sp = 0u;
    for (;;) {
        sum = 0u; cnt = 0u; mine = 0u;
#pragma unroll
        for (unsigned j = 0; j < 16; ++j) { const unsigned c = xb_ld(&bar[XB_XCNT(j)]); sum += c; cnt += (c > 0u) ? 1u : 0u; mine = (j == x) ? c : mine; }
        if (sum == G) break;
        __builtin_amdgcn_s_sleep(1);
        if ((++sp & 255u) == 0u) { if (xb_ld(&bar[XB_TMO])) break; if (sp > XB_SPIN_CAP) { atomicAdd(&bar[XB_TMO], 1u); break; } }
    }
    nloc = mine > 0u ? mine : 1u; nx = cnt > 0u ? cnt : 1u;
}
__device__ __forceinline__ void xcd_barrier(const XcdBarrier& b) {
    asm volatile("s_waitcnt vmcnt(0)" ::: "memory");
    __syncthreads();
    if (threadIdx.x == 0) {
        unsigned* bar = b.bar;
        __builtin_amdgcn_s_waitcnt(0);
        unsigned nloc = b.st[0], nx = b.st[1];
        if (nloc == 0u) { xcd_barrier_complete(bar, b.x, nloc, nx); b.st[0] = nloc; b.st[1] = nx; }
        const unsigned old = xb_add(&bar[XB_XSUB(b.x)], 1u);
        const unsigned gen = old / nloc;
        if (old + 1u == (gen + 1u) * nloc) {
            __builtin_amdgcn_fence(__ATOMIC_RELEASE, "agent");
            asm volatile("s_waitcnt vmcnt(0)" ::: "memory");
            const unsigned og = xb_add(&bar[XB_TOP], 1u);
            const unsigned tg = og / nx;
            if (og + 1u == (tg + 1u) * nx) xb_add(&bar[XB_TOPGEN], 1u);
            else XB_SPIN(xb_ld(&bar[XB_TOPGEN]) == tg, bar);
            __builtin_amdgcn_fence(__ATOMIC_ACQUIRE, "agent");
            xb_add(&bar[XB_XGEN(b.x)], 1u);
            asm volatile("s_waitcnt vmcnt(0)" ::: "memory");
        } else {
            XB_SPIN(xb_ld(&bar[XB_XGEN(b.x)]) == gen, bar);
            __builtin_amdgcn_fence(__ATOMIC_ACQUIRE, "agent");
            asm volatile("s_waitcnt vmcnt(0)" ::: "memory");
        }
    }
    __syncthreads();
}

struct Args { const float* in[26]; float* out; unsigned char* ws; int ph_lo, ph_hi; };
enum { I_XP = 0, I_XS, I_SPOOL, I_SCONV, I_PP, I_PS, I_WIN, I_POOLW, I_POOLS, I_SLNG, I_SLNB, I_SGUW, I_SGUB, I_CONVW, I_WBRA, I_WBRB, I_WBRC, I_WO, I_LN1G, I_LN1B, I_WGU, I_WDN, I_WPE, I_WPEG, I_LN2G, I_LN2B };

struct TrP { const float* W; bf16_t* WT; int N, ldt, koff, row_off, mode, r; };
__device__ __forceinline__ void tr_load(const TrP& p, int lane, float (&v)[32]) {
    const int nblk = p.N / 32, kb = p.r / nblk, nb = p.r - kb * nblk, k0 = 64 * kb, n0 = 32 * nb;
    const float* src = p.W + (size_t)(k0 + (lane >> 5)) * p.N + n0 + (lane & 31);
#pragma unroll
    for (int i = 0; i < 32; ++i) v[i] = src[(size_t)(2 * i) * p.N];
}
__device__ __forceinline__ void tr_store(const TrP& p, LAS float* scr, int lane, const float (&v)[32]) {
    const int nblk = p.N / 32, kb = p.r / nblk, nb = p.r - kb * nblk, k0 = 64 * kb, n0 = 32 * nb;
#pragma unroll
    for (int i = 0; i < 32; ++i) { const int kk = 2 * i + (lane >> 5); scr[kk * 33 + (lane & 31)] = v[i]; }
    asm volatile("s_waitcnt lgkmcnt(0)" ::: "memory");
    const int c = lane & 7;
    int d0 = n0;
    if (p.mode == 1) { const int half = n0 >= DFF ? 1 : 0, ff = n0 - half * DFF; d0 = (ff >> 7) * 256 + half * 128 + (ff & 127); }
    d0 += p.row_off;
#pragma unroll
    for (int j = 0; j < 4; ++j) { const int n = (lane >> 3) + 8 * j; const LAS float* sp = scr + (8 * c) * 33 + n;
        u32x4 o; o.x = cvt_pk_bf16(sp[0 * 33], sp[1 * 33]); o.y = cvt_pk_bf16(sp[2 * 33], sp[3 * 33]); o.z = cvt_pk_bf16(sp[4 * 33], sp[5 * 33]); o.w = cvt_pk_bf16(sp[6 * 33], sp[7 * 33]);
        *(u32x4*)(p.WT + (size_t)(d0 + n) * p.ldt + p.koff + k0 + 8 * c) = o; }
    asm volatile("s_waitcnt lgkmcnt(0)" ::: "memory");
}

__device__ __forceinline__ void convert_weights(const Args& a, int l, LAS unsigned char* lds, int gw, int NGW, int wave, int lane) {
    unsigned char* ws = a.ws;
    LAS float* scr = (LAS float*)(lds + wave * 8704);
    constexpr int I0 = 32 * 320, I1 = I0 + 16 * 64, I2 = I1 + 8 * 64, I3 = I2 + 32 * 64, I4 = I3 + 32 * 352, I5 = I4 + 32 * 64, I6 = I5 + 88 * 64, I7 = I6 + 4 * 64;
#define TR_PARAMS(P, it) do { (P).koff = 0; (P).row_off = 0; (P).mode = 0; \
        if ((it) < I0)      { (P).r = (it);      (P).W = a.in[I_WIN] + (size_t)l * DM * NIN;      (P).N = NIN;     (P).WT = (bf16_t*)(ws + WS_WIN); (P).ldt = DM; } \
        else if ((it) < I1) { (P).r = (it) - I0; (P).W = a.in[I_WBRB] + (size_t)l * 1024 * DM;    (P).N = DM;      (P).WT = (bf16_t*)(ws + WS_WBR); (P).ldt = DM; (P).koff = 512; } \
        else if ((it) < I2) { (P).r = (it) - I1; (P).W = a.in[I_WBRC] + (size_t)l * 512 * DM;     (P).N = DM;      (P).WT = (bf16_t*)(ws + WS_WBR); (P).ldt = DM; (P).koff = 1536; } \
        else if ((it) < I3) { (P).r = (it) - I2; (P).W = a.in[I_WO] + (size_t)l * DM * DM;        (P).N = DM;      (P).WT = (bf16_t*)(ws + WS_WO);  (P).ldt = DM; } \
        else if ((it) < I4) { (P).r = (it) - I3; (P).W = a.in[I_WGU] + (size_t)l * DM * 2 * DFF;  (P).N = 2 * DFF; (P).WT = (bf16_t*)(ws + WS_WGU); (P).ldt = DM; (P).mode = 1; } \
        else if ((it) < I5) { (P).r = (it) - I4; (P).W = a.in[I_WPEG] + (size_t)l * DM * DM;      (P).N = DM;      (P).WT = (bf16_t*)(ws + WS_WGU); (P).ldt = DM; (P).row_off = 2 * DFF; } \
        else if ((it) < I6) { (P).r = (it) - I5; (P).W = a.in[I_WDN] + (size_t)l * DFF * DM;      (P).N = DM;      (P).WT = (bf16_t*)(ws + WS_WDN); (P).ldt = LD_ACT; } \
        else                { (P).r = (it) - I6; (P).W = a.in[I_WPE] + (size_t)l * PLE * DM;      (P).N = DM;      (P).WT = (bf16_t*)(ws + WS_WPE); (P).ldt = PLE; } } while (0)
    {
        int it = gw; TrP P; float v[32];
        if (it < I7) { TR_PARAMS(P, it); tr_load(P, lane, v); }
        while (it < I7) {
            const int itn = it + NGW; const bool hn = itn < I7;
            TrP Pn = P; float vn[32];
            if (hn) { TR_PARAMS(Pn, itn); tr_load(Pn, lane, vn); }
            tr_store(P, scr, lane, v);
            if (hn) { P = Pn;
#pragma unroll
                for (int i = 0; i < 32; ++i) v[i] = vn[i]; }
            it = itn;
        }
    }
#undef TR_PARAMS
    for (int r = gw; r < 4096; r += NGW) {
        const int g = r >> 10, cb = (r >> 5) & 31, nb = r & 31, n = nb * 64 + lane;
        const float* pw = a.in[I_POOLW] + ((size_t)(l * 4 + g) * 128 + cb * 4) * 128; const float* sc = a.in[I_POOLS] + l * 512 + g * 128;
        const float* wa = a.in[I_WBRA] + (size_t)l * 512 * DM + (size_t)(g * 128) * DM + n;
        float s0 = 0.f, s1 = 0.f, s2 = 0.f, s3 = 0.f;
        for (int d = 0; d < 128; ++d) { const float wv = wa[(size_t)d * DM] * sc[d]; s0 += pw[d] * wv; s1 += pw[128 + d] * wv; s2 += pw[256 + d] * wv; s3 += pw[384 + d] * wv; }
        u32x2 o; o.x = cvt_pk_bf16(s0, s1); o.y = cvt_pk_bf16(s2, s3);
        *(u32x2*)((bf16_t*)(ws + WS_WBR) + (size_t)n * DM + g * 128 + cb * 4) = o;
    }
    const float* sw = a.in[I_SGUW] + (size_t)l * 131072; bf16_t* so = (bf16_t*)(ws + WS_SGW);
    for (int i = gw * 64 + lane; i < 131072 / 2; i += NGW * 64) { const int e = 2 * i, t = (e >> 7) & 127, s = e & 127;
        const float v0 = s <= t ? sw[e] : 0.f, v1 = (s + 1) <= t ? sw[e + 1] : 0.f; ((unsigned*)so)[i] = cvt_pk_bf16(v0, v1); }
}

__device__ __forceinline__ void convert_rows(const float* srcA, size_t nA8, const float* srcB, size_t n8, bf16_t* dst, int gtid, int NT) {
    for (size_t i0 = gtid; i0 < n8; i0 += (size_t)4 * NT) {
        f32x4 v[4][2];
#pragma unroll
        for (int u = 0; u < 4; ++u) { const size_t i = i0 + (size_t)u * NT; if (i < n8) { const float* s = i < nA8 ? srcA + i * 8 : srcB + (i - nA8) * 8; v[u][0] = *(const f32x4*)s; v[u][1] = *(const f32x4*)(s + 4); } }
#pragma unroll
        for (int u = 0; u < 4; ++u) { const size_t i = i0 + (size_t)u * NT; if (i < n8) *(u32x4*)(dst + i * 8) = pg8::pack8(v[u][0], v[u][1]); }
    }
}

__device__ __forceinline__ void ln_finish(float (&x)[32], float s, int row, const float* gam, const float* bet, bf16_t* outb, float* outf, int lane) {
    const float mean = wave_sum(s) * (1.0f / DM); float q = 0.f;
#pragma unroll
    for (int k = 0; k < 32; ++k) { x[k] -= mean; q += x[k] * x[k]; }
    const float rstd = rsqrtf(wave_sum(q) * (1.0f / DM) + LN_EPS);
#pragma unroll
    for (int j = 0; j < 4; ++j) { const int c = j * 512 + lane * 8;
        const f32x4 g0 = *(const f32x4*)(gam + c), g1 = *(const f32x4*)(gam + c + 4), b0 = *(const f32x4*)(bet + c), b1 = *(const f32x4*)(bet + c + 4);
        f32x4 y0, y1;
#pragma unroll
        for (int k = 0; k < 4; ++k) { y0[k] = x[j * 8 + k] * rstd * g0[k] + b0[k]; y1[k] = x[j * 8 + 4 + k] * rstd * g1[k] + b1[k]; }
        if (outf) { *(f32x4*)(outf + (size_t)row * DM + c) = y0; *(f32x4*)(outf + (size_t)row * DM + c + 4) = y1; }
        else *(u32x4*)(outb + (size_t)row * DM + c) = pg8::pack8(y0, y1); }
}
__device__ __forceinline__ void ln_phase(const bf16_t* T, const bf16_t* R, const bf16_t* P, const bf16_t* PART, int nsl, const float* gam, const float* bet, bf16_t* outb, float* outf, int gw, int NGW, int lane) {
    for (int base = gw; base < MP; base += 4 * NGW) {
        u32x4 w[4][4];
#pragma unroll
        for (int u = 0; u < 4; ++u) { const int row = base + u * NGW; if (row < MP) { const bf16_t* tp = T + (size_t)row * DM + lane * 8;
#pragma unroll
            for (int j = 0; j < 4; ++j) w[u][j] = *(const u32x4*)(tp + j * 512); } }
#pragma unroll
        for (int u = 0; u < 4; ++u) { const int row = base + u * NGW; if (row < MP) {
            float x[32]; float s = 0.f;
#pragma unroll
            for (int j = 0; j < 4; ++j) { float f[8]; unpack8(w[u][j], f);
#pragma unroll
                for (int k = 0; k < 8; ++k) { x[j * 8 + k] = f[k]; s += f[k]; } }
            ln_finish(x, s, row, gam, bet, outb, outf, lane);
        } }
    }
    const int G_ = NGW >> 3, bid_ = gw >> 3, wv_ = gw & 7;
    for (int sr = wv_ * G_ + bid_; sr < MS; sr += NGW) {
        const int row = MP + sr;
        float x[32];
        { const bf16_t* rp = R + (size_t)row * DM + lane * 8; u32x4 w[4];
#pragma unroll
          for (int j = 0; j < 4; ++j) w[j] = *(const u32x4*)(rp + j * 512);
#pragma unroll
          for (int j = 0; j < 4; ++j) { float f[8]; unpack8(w[j], f);
#pragma unroll
              for (int k = 0; k < 8; ++k) x[j * 8 + k] = ALPHA * f[k]; } }
        if (P) { const bf16_t* pp = P + (size_t)row * DM + lane * 8; u32x4 w[4];
#pragma unroll
          for (int j = 0; j < 4; ++j) w[j] = *(const u32x4*)(pp + j * 512);
#pragma unroll
          for (int j = 0; j < 4; ++j) { float f[8]; unpack8(w[j], f);
#pragma unroll
              for (int k = 0; k < 8; ++k) x[j * 8 + k] += f[k]; } }
        for (int sl0 = 0; sl0 < nsl; sl0 += 4) { u32x4 w[4][4];
#pragma unroll
          for (int q = 0; q < 4; ++q) if (sl0 + q < nsl) { const bf16_t* pp = PART + ((size_t)(sl0 + q) * MS + sr) * DM + lane * 8;
#pragma unroll
              for (int j = 0; j < 4; ++j) w[q][j] = *(const u32x4*)(pp + j * 512); }
#pragma unroll
          for (int q = 0; q < 4; ++q) if (sl0 + q < nsl) {
#pragma unroll
              for (int j = 0; j < 4; ++j) { float f[8]; unpack8(w[q][j], f);
#pragma unroll
                  for (int k = 0; k < 8; ++k) x[j * 8 + k] += f[k]; } } }
        float s = 0.f;
#pragma unroll
        for (int k = 0; k < 32; ++k) s += x[k];
        ln_finish(x, s, row, gam, bet, outb, outf, lane);
    }
}

__device__ __forceinline__ void mix_phase(const Args& a, int l, LAS unsigned char* lds, const bf16_t* __restrict__ Z, bf16_t* __restrict__ Y, const int tid, const int bid) {
    const int lane = tid & 63, wave = __builtin_amdgcn_readfirstlane(tid >> 6), g = wave, quad = lane >> 4, l15 = lane & 15;
    LAS f32x2* stats = (LAS f32x2*)lds;
    const bf16_t* sguw = (const bf16_t*)(a.ws + WS_SGW);
    float* __restrict__ out = a.out;
    for (int item = bid; item < 272; item += gridDim.x) {
        const bool sample = item >= 256;
        const int sb = item - 256, b = item >> 5;
        const int row0 = sample ? MP + sb * 32 : item * 128, T = sample ? 32 : 128, tseq0 = sample ? 0 : (item & 31) * 128;
        { int tidA = tid; asm volatile("" : "+v"(tidA)); const int lane = tidA & 63;
        for (int r0 = wave; r0 < T; r0 += 32) {
            u32x4 wv[4][2];
#pragma unroll
            for (int q = 0; q < 4; ++q) { const int r = r0 + 8 * q; if (r < T) { const bf16_t* vp = Z + (size_t)(row0 + r) * NZ + 1536 + lane * 8; wv[q][0] = *(const u32x4*)vp; wv[q][1] = *(const u32x4*)(vp + 512); } }
#pragma unroll
            for (int q = 0; q < 4; ++q) { const int r = r0 + 8 * q; if (r < T) {
                float x[16]; { float f[8]; unpack8(wv[q][0], f);
#pragma unroll
                    for (int k = 0; k < 8; ++k) x[k] = f[k];
                    unpack8(wv[q][1], f);
#pragma unroll
                    for (int k = 0; k < 8; ++k) x[8 + k] = f[k]; }
                float s = 0.f;
#pragma unroll
                for (int k = 0; k < 16; ++k) s += x[k];
                const float mean = wave_sum(s) * (1.0f / 1024.0f); float q2 = 0.f;
#pragma unroll
                for (int k = 0; k < 16; ++k) { x[k] -= mean; q2 += x[k] * x[k]; }
                const float rstd = rsqrtf(wave_sum(q2) * (1.0f / 1024.0f) + LN_EPS);
                if (lane == 0) stats[r] = (f32x2){mean, rstd};
                if (sample) {
                    float* o = out + O_SGV + ((size_t)(l * 16 + sb) * 32 + r) * 1024;
#pragma unroll
                    for (int h = 0; h < 2; ++h) { const int c = h * 512 + lane * 8; const float* gp = a.in[I_SLNG] + l * 1024 + c; const float* bp = a.in[I_SLNB] + l * 1024 + c;
                        const f32x4 g0 = *(const f32x4*)gp, g1 = *(const f32x4*)(gp + 4), b0 = *(const f32x4*)bp, b1 = *(const f32x4*)(bp + 4);
                        f32x4 y0, y1;
#pragma unroll
                        for (int k = 0; k < 4; ++k) { y0[k] = x[h * 8 + k] * rstd * g0[k] + b0[k]; y1[k] = x[h * 8 + 4 + k] * rstd * g1[k] + b1[k]; }
                        *(f32x4*)(o + c) = y0; *(f32x4*)(o + c + 4) = y1; }
                }
            } }
        }
        }
        __syncthreads();
        {
        int tidB = tid; asm volatile("" : "+v"(tidB)); const int l15b = tidB & 15, quadb = (tidB >> 4) & 3;
        const unsigned offV = 2u * (unsigned)(quadb * 8 * NZ + 4 * l15b), offW = 2u * (unsigned)(l15b * 128 + quadb * 8), offU = 2u * (unsigned)(l15b * NZ + 16 * quadb), offY = 2u * (unsigned)(l15b * DM + 16 * quadb);
#pragma unroll 1
        for (int hb = 0; hb < 2; ++hb) {
            const int cbase = g * 128 + hb * 64;
            u32x2 xr[4][8];
#pragma unroll
            for (int kb = 0; kb < 4; ++kb) if (kb * 32 < T) {
#pragma unroll
                for (int j = 0; j < 8; ++j) xr[kb][j] = *(const u32x2*)(uptr(Z + (size_t)(row0 + kb * 32 + j) * NZ + 1536 + cbase) + offV); }
            const f32x4 gam4 = *(const f32x4*)(uptr(a.in[I_SLNG] + l * 1024 + cbase) + 16u * (unsigned)l15b), bet4 = *(const f32x4*)(uptr(a.in[I_SLNB] + l * 1024 + cbase) + 16u * (unsigned)l15b);
            bf16x8 Vf[4][4];
#pragma unroll
            for (int kb = 0; kb < 4; ++kb) {
                if (kb * 32 < T) {
                    float vn[4][8];
#pragma unroll
                    for (int j = 0; j < 8; ++j) { const f32x2 st = stats[kb * 32 + quadb * 8 + j];
                        vn[0][j] = (bflo(xr[kb][j].x) - st.x) * st.y * gam4[0] + bet4[0]; vn[1][j] = (bfhi(xr[kb][j].x) - st.x) * st.y * gam4[1] + bet4[1];
                        vn[2][j] = (bflo(xr[kb][j].y) - st.x) * st.y * gam4[2] + bet4[2]; vn[3][j] = (bfhi(xr[kb][j].y) - st.x) * st.y * gam4[3] + bet4[3]; }
#pragma unroll
                    for (int q = 0; q < 4; ++q) { u32x4 pk; pk.x = cvt_pk_bf16(vn[q][0], vn[q][1]); pk.y = cvt_pk_bf16(vn[q][2], vn[q][3]); pk.z = cvt_pk_bf16(vn[q][4], vn[q][5]); pk.w = cvt_pk_bf16(vn[q][6], vn[q][7]);
                        Vf[q][kb] = __builtin_bit_cast(bf16x8, pk); }
                } else {
#pragma unroll
                    for (int q = 0; q < 4; ++q) Vf[q][kb] = (bf16x8){0, 0, 0, 0, 0, 0, 0, 0}; }
            }
#pragma unroll
            for (int tb = 0; tb < 8; ++tb) {
                if (tb * 16 < T) {
                    bf16x8 wf[4];
#pragma unroll
                    for (int kb = 0; kb <= (tb >> 1); ++kb) wf[kb] = *(const bf16x8*)(uptr(sguw + (size_t)(g * 128 + tb * 16) * 128 + kb * 32) + offW);
                    const char* up = uptr(Z + (size_t)(row0 + tb * 16) * NZ + 512 + cbase) + offU;
                    const u32x4 u0 = *(const u32x4*)up, u1 = *(const u32x4*)(up + 16);
                    const float bias = *(const float*)(uptr(a.in[I_SGUB] + (l * 8 + g) * 128 + tb * 16) + 4u * (unsigned)l15b);
                    f32x4 acc[4];
#pragma unroll
                    for (int q = 0; q < 4; ++q) { acc[q] = (f32x4){0.f, 0.f, 0.f, 0.f};
#pragma unroll
                        for (int kb = 0; kb <= (tb >> 1); ++kb) acc[q] = __builtin_amdgcn_mfma_f32_16x16x32_bf16(Vf[q][kb], wf[kb], acc[q], 0, 0, 0); }
                    float uf[16]; { float f[8]; unpack8(u0, f);
#pragma unroll
                        for (int k = 0; k < 8; ++k) uf[k] = f[k];
                        unpack8(u1, f);
#pragma unroll
                        for (int k = 0; k < 8; ++k) uf[8 + k] = f[k]; }
                    float yo[16];
#pragma unroll
                    for (int jj = 0; jj < 4; ++jj)
#pragma unroll
                        for (int q = 0; q < 4; ++q) yo[4 * jj + q] = uf[4 * jj + q] * (acc[q][jj] + bias);
                    char* yp = uptr(Y + (size_t)(row0 + tb * 16) * DM + 512 + cbase) + offY;
                    *(u32x4*)yp = pg8::pack8((f32x4){yo[0], yo[1], yo[2], yo[3]}, (f32x4){yo[4], yo[5], yo[6], yo[7]});
                    *(u32x4*)(yp + 16) = pg8::pack8((f32x4){yo[8], yo[9], yo[10], yo[11]}, (f32x4){yo[12], yo[13], yo[14], yo[15]});
                }
            }
        }
        }
        asm volatile("" ::: "memory");
        {
            const int cg8 = (tid & 63) * 8, rseg = tid >> 6, rl = T >> 3, rb = rseg * rl;
            {
                const int win = 2 << ((tid & 63) >> 4);
                float S[8];
#pragma unroll
                for (int j = 0; j < 8; ++j) S[j] = 0.f;
                for (int r = rb - (win - 1); r < rb + rl; ++r) {
                    float av[8]; const int tabs = tseq0 + r;
                    if (tabs >= 0) { const u32x4 w = *(const u32x4*)(Z + (size_t)(row0 + r) * NZ + cg8); unpack8(w, av); }
                    else if (sample) { const float* hp = a.in[I_SPOOL] + ((size_t)(l * 16 + sb) * 15 + (15 + tabs)) * 512 + cg8; const f32x4 h0 = *(const f32x4*)hp, h1 = *(const f32x4*)(hp + 4);
#pragma unroll
                        for (int j = 0; j < 4; ++j) { av[j] = h0[j]; av[4 + j] = h1[j]; } }
                    else {
#pragma unroll
                        for (int j = 0; j < 8; ++j) av[j] = 0.f; }
#pragma unroll
                    for (int j = 0; j < 8; ++j) S[j] += av[j];
                    if (r >= rb) {
                        const int cnt = sample ? win : min(tabs + 1, win); const float inv = 1.0f / (float)cnt;
                        f32x4 p0, p1;
#pragma unroll
                        for (int j = 0; j < 4; ++j) { p0[j] = S[j] * inv - av[j]; p1[j] = S[4 + j] * inv - av[4 + j]; }
                        *(u32x4*)(Y + (size_t)(row0 + r) * DM + cg8) = pg8::pack8(p0, p1);
                        float* np = nullptr;
                        if (sample) { if (r >= 17) np = out + O_NPS + ((size_t)(l * 16 + sb) * 15 + (r - 17)) * 512 + cg8; }
                        else if (tabs >= 4096 - 15) np = out + O_NPP + ((size_t)(l * 8 + b) * 15 + (tabs - (4096 - 15))) * 512 + cg8;
                        if (np) { *(f32x4*)np = (f32x4){av[0], av[1], av[2], av[3]}; *(f32x4*)(np + 4) = (f32x4){av[4], av[5], av[6], av[7]}; }
                        const int rd = r - win + 1, td = tseq0 + rd; float dv[8];
                        if (td >= 0) { const u32x4 w = *(const u32x4*)(Z + (size_t)(row0 + rd) * NZ + cg8); unpack8(w, dv); }
                        else if (sample) { const float* hp = a.in[I_SPOOL] + ((size_t)(l * 16 + sb) * 15 + (15 + td)) * 512 + cg8; const f32x4 h0 = *(const f32x4*)hp, h1 = *(const f32x4*)(hp + 4);
#pragma unroll
                            for (int j = 0; j < 4; ++j) { dv[j] = h0[j]; dv[4 + j] = h1[j]; } }
                        else {
#pragma unroll
                            for (int j = 0; j < 8; ++j) dv[j] = 0.f; }
#pragma unroll
                        for (int j = 0; j < 8; ++j) S[j] -= dv[j];
                    }
                }
            }
            {
            int tidC = tid; asm volatile("" : "+v"(tidC));
            const unsigned cg8 = (unsigned)(tidC & 63) * 8u, cgb = cg8 * 2u; const int rseg = __builtin_amdgcn_readfirstlane(tidC >> 6), rl = T >> 3, rb = rseg * rl, rend = rb + rl;
            {
                const float* cw = a.in[I_CONVW] + (size_t)l * 3 * 512 + cg8;
                float w0[8], w1[8], w2[8], p2[8], p1[8];
#pragma unroll
                for (int j = 0; j < 8; ++j) { w0[j] = cw[j]; w1[j] = cw[512 + j]; w2[j] = cw[1024 + j]; p2[j] = 0.f; p1[j] = 0.f; }
                #pragma unroll 1
                for (int r0 = rb - 2; r0 < rend; r0 += 2) {
                    float ci[2][8]; u32x4 wbv[2];
#pragma unroll
                    for (int i = 0; i < 2; ++i) { const int r = r0 + i; if (r < rend) { const int tabs = tseq0 + r;
                        if (tabs >= 0) { const char* zp = uptr(Z + (size_t)(row0 + r) * NZ) + cgb; const u32x4 wc_ = *(const u32x4*)(zp + 2 * 3072), wx = *(const u32x4*)(zp + 2 * 3584); float fc[8], fx[8]; unpack8(wc_, fc); unpack8(wx, fx);
#pragma unroll
                            for (int j = 0; j < 8; ++j) ci[i][j] = fc[j] * fx[j]; }
                        else if (sample) { const float* hp = a.in[I_SCONV] + ((size_t)(l * 16 + sb) * 2 + (2 + tabs)) * 512 + cg8; const f32x4 h0 = *(const f32x4*)hp, h1 = *(const f32x4*)(hp + 4);
#pragma unroll
                            for (int j = 0; j < 4; ++j) { ci[i][j] = h0[j]; ci[i][4 + j] = h1[j]; } }
                        else {
#pragma unroll
                            for (int j = 0; j < 8; ++j) ci[i][j] = 0.f; }
                        if (r >= rb) wbv[i] = *(const u32x4*)(uptr(Z + (size_t)(row0 + r) * NZ + 2560) + cgb);
                    } }
#pragma unroll
                    for (int i = 0; i < 2; ++i) { const int r = r0 + i; if (r < rend) { const int tabs = tseq0 + r;
                        if (r >= rb) {
                            float fb[8]; unpack8(wbv[i], fb);
                            f32x4 y0, y1;
#pragma unroll
                            for (int j = 0; j < 4; ++j) { y0[j] = fb[j] * (w0[j] * p2[j] + w1[j] * p1[j] + w2[j] * ci[i][j]); y1[j] = fb[4 + j] * (w0[4 + j] * p2[4 + j] + w1[4 + j] * p1[4 + j] + w2[4 + j] * ci[i][4 + j]); }
                            *(u32x4*)(uptr(Y + (size_t)(row0 + r) * DM + 1536) + cgb) = pg8::pack8(y0, y1);
                            float* np = nullptr;
                            if (sample) { if (r >= 30) np = out + O_NCS + ((size_t)(l * 16 + sb) * 2 + (r - 30)) * 512 + cg8; }
                            else if (tabs >= 4094) np = out + O_NCP + ((size_t)(l * 8 + b) * 2 + (tabs - 4094)) * 512 + cg8;
                            if (np) { *(f32x4*)np = (f32x4){ci[i][0], ci[i][1], ci[i][2], ci[i][3]}; *(f32x4*)(np + 4) = (f32x4){ci[i][4], ci[i][5], ci[i][6], ci[i][7]}; }
                        }
#pragma unroll
                        for (int j = 0; j < 8; ++j) { p2[j] = p1[j]; p1[j] = ci[i][j]; }
                    } }
                }
            }
            }
        }
        __syncthreads();
    }
}

__global__ void __launch_bounds__(512, 2) fwd_megakernel(Args a) {
    extern __shared__ __attribute__((aligned(16))) unsigned char lds_raw[];
    LAS unsigned char* lds = (LAS unsigned char*)lds_raw;
    cg::grid_group grid = cg::this_grid();
    const int G = gridDim.x, NGW = G * 8, NT = G * 512;
#define FRESH_IDS() int tid = threadIdx.x; asm volatile("" : "+v"(tid)); int bid = blockIdx.x; asm volatile("" : "+s"(bid)); \
    const int lane = tid & 63, wave = __builtin_amdgcn_readfirstlane(tid >> 6), gw = bid * 8 + wave, gtid = bid * 512 + tid; (void)lane; (void)gw; (void)gtid
    unsigned char* ws = a.ws;
    if (threadIdx.x < 4) ((volatile LAS unsigned*)(lds + 131072 + 64))[threadIdx.x] = 0u;
    __syncthreads();
    XcdBarrier xbar = xcd_barrier_post((unsigned*)ws, (volatile LAS unsigned*)(lds + 131072 + 64));
    grid.sync();
    bf16_t* XB = (bf16_t*)((unsigned char*)a.out + DO_XB); bf16_t* MG = (bf16_t*)((unsigned char*)a.out + DO_MG);
    bf16_t* Zb = (bf16_t*)(ws + WS_Z); bf16_t* Gb = (bf16_t*)(ws + WS_G); bf16_t* Yb = (bf16_t*)(ws + WS_Y);
    bf16_t* Tb = (bf16_t*)(ws + WS_T); bf16_t* X1 = (bf16_t*)(ws + WS_X1); bf16_t* ACT = (bf16_t*)(ws + WS_ACT); bf16_t* PE = (bf16_t*)(ws + WS_PE);
#ifndef PHMASK
#define PHMASK 0xffff
#endif
#define PH_ON(i) (((PHMASK) >> (i)) & 1)
#ifndef REPNG_MASK
#define REPNG_MASK 0
#endif
#define NREPNG(i) ((((REPNG_MASK) >> (i)) & 1) ? 2 : 1)
#ifndef REPG_MASK
#define REPG_MASK 0
#endif
#define NREPG(i) ((((REPG_MASK) >> (i)) & 1) ? 2 : 1)
#define RUN(k) (a.ph_lo <= (k) && (k) < a.ph_hi)
#define SEAM(k) do { if (RUN(k) && RUN((k) + 1)) xcd_barrier(xbar); } while (0)
#define SEAM_NOW() xcd_barrier(xbar)

    for (int rep = 0; rep < NREPNG(0); ++rep) if (RUN(0) && PH_ON(0)) {
        if (rep) SEAM_NOW();
        FRESH_IDS();
        convert_weights(a, 0, lds, gw, NGW, wave, lane);
        convert_rows(a.in[I_XP], (size_t)MP * DM / 8, a.in[I_XS], (size_t)MT * DM / 8, XB, gtid, NT);
        convert_rows(a.in[I_PP], (size_t)MP * PLE / 8, a.in[I_PS], (size_t)MT * PLE / 8, (bf16_t*)(ws + WS_PB0), gtid, NT);
        convert_rows(a.in[I_PP] + (size_t)MP * PLE, (size_t)MP * PLE / 8, a.in[I_PS] + (size_t)MS * PLE, (size_t)MT * PLE / 8, (bf16_t*)(ws + WS_PB1), gtid, NT);
    }
    SEAM(0);
    for (int l = 0; l < 2; ++l) {
        const int pb = 1 + 8 * l;
        for (int rep = 0; rep < NREPG(1); ++rep) if (RUN(pb + 0) && PH_ON(1)) {
            if (rep) SEAM_NOW();
            FRESH_IDS(); pg8::Gemm g{XB, (const bf16_t*)(ws + WS_WIN), DM, 1, pg8::pack3(DM / 64, 0, 0), 0u, 0}; pg8::Order S; S.init(MT / 256, NIN / 256, G, bid, 1);
            pg8::EpiIn E{Zb, Gb};
            pg8::gemm_phase<pg8::EpiIn, true, true>(lds, g, S, E, tid);
        }
        SEAM(pb + 0);
        for (int rep = 0; rep < NREPNG(1); ++rep) if (RUN(pb + 1) && PH_ON(2)) { if (rep) SEAM_NOW(); FRESH_IDS(); mix_phase(a, l, lds, Zb, Yb, tid, bid); }
        SEAM(pb + 1);
        for (int rep = 0; rep < NREPG(3); ++rep) if (RUN(pb + 2) && PH_ON(3)) {
            if (rep) SEAM_NOW();
            FRESH_IDS(); pg8::Gemm g{Yb, (const bf16_t*)(ws + WS_WBR), DM, 3, pg8::pack3(8, 16, 8), pg8::pack3(0, 8, 24), 0}; pg8::Order S; S.init(MT / 256, DM / 256, G, bid, 3);
            pg8::EpiBr E{Gb, MG};
            pg8::gemm_phase<pg8::EpiBr, true, true>(lds, g, S, E, tid);
        }
        SEAM(pb + 2);
        if (RUN(pb + 3)) {
            if (PH_ON(4)) { FRESH_IDS(); pg8::Gemm g{MG, (const bf16_t*)(ws + WS_WO), DM, 1, pg8::pack3(DM / 64, 0, 0), 0u, 0}; pg8::Order S; S.init(MP / 256, DM / 256, G, bid, 1); S.slices(MP / 256, MS / 256, 8); g.nts = 4;
              pg8::EpiRes E{XB, nullptr, Tb, (bf16_t*)(ws + WS_PART)};
              pg8::gemm_phase<pg8::EpiRes, true, true>(lds, g, S, E, tid); }
            if (PH_ON(5)) { FRESH_IDS(); pg8::Gemm g{(const bf16_t*)(ws + (l ? WS_PB1 : WS_PB0)), (const bf16_t*)(ws + WS_WPE), PLE, 1, pg8::pack3(PLE / 64, 0, 0), 0u, 0}; pg8::Order S; S.init(MT / 256, DM / 256, G, G - 1 - bid, 1);
              pg8::EpiStore E{PE, DM};
              pg8::gemm_phase<pg8::EpiStore, true, true>(lds, g, S, E, tid); }
        }
        SEAM(pb + 3);
        for (int rep = 0; rep < NREPNG(2); ++rep) if (RUN(pb + 4) && PH_ON(6)) { if (rep) SEAM_NOW(); FRESH_IDS(); ln_phase(Tb, XB, nullptr, (const bf16_t*)(ws + WS_PART), 8, a.in[I_LN1G] + l * DM, a.in[I_LN1B] + l * DM, X1, nullptr, gw, NGW, lane); }
        SEAM(pb + 4);
        if (RUN(pb + 5) && PH_ON(7)) {
            FRESH_IDS(); pg8::Gemm g{X1, (const bf16_t*)(ws + WS_WGU), DM, 1, pg8::pack3(DM / 64, 0, 0), 0u, 0}; pg8::Order S; S.init(MT / 256, NGU / 256, G, bid, 1);
            pg8::EpiGu E{ACT, PE};
            pg8::gemm_phase<pg8::EpiGu, true, true>(lds, g, S, E, tid);
        }
        SEAM(pb + 5);
        for (int rep = 0; rep < NREPG(8); ++rep) if (RUN(pb + 6) && PH_ON(8)) {
            if (rep) SEAM_NOW();
            FRESH_IDS(); pg8::Gemm g{ACT, (const bf16_t*)(ws + WS_WDN), LD_ACT, 1, pg8::pack3(DFF / 64, 0, 0), 0u, 0}; pg8::Order S; S.init(MP / 256, DM / 256, G, bid, 1); S.slices(MP / 256, MS / 256, 11); g.nts = 8;
            pg8::EpiRes E{X1, PE, Tb, (bf16_t*)(ws + WS_PART)};
            pg8::gemm_phase<pg8::EpiRes, true, true>(lds, g, S, E, tid);
        }
        SEAM(pb + 6);
        for (int rep = 0; rep < NREPNG(3); ++rep) if (RUN(pb + 7) && PH_ON(9)) {
            if (rep) SEAM_NOW();
            FRESH_IDS();
            if (l == 0) { ln_phase(Tb, X1, PE, (const bf16_t*)(ws + WS_PART), 11, a.in[I_LN2G], a.in[I_LN2B], XB, nullptr, gw, NGW, lane); convert_weights(a, 1, lds, gw, NGW, wave, lane); }
            else ln_phase(Tb, X1, PE, (const bf16_t*)(ws + WS_PART), 11, a.in[I_LN2G] + DM, a.in[I_LN2B] + DM, nullptr, a.out, gw, NGW, lane);
        }
        if (l == 0) SEAM(pb + 7);
    }
#undef RUN
#undef SEAM
}

extern "C" void kernel_launch(void* const* d_in, const int* in_sizes, int n_in, void* d_out, int out_size, void* d_ws, size_t ws_size, hipStream_t stream) {
    static int grid = 0;
    if (grid == 0) {
        if (n_in != 26 || ws_size < WS_END) { fprintf(stderr, "kernel_launch: expected 26 inputs and >= %zu bytes of workspace (got %d, %zu)\n", (size_t)WS_END, n_in, ws_size); grid = -1; return; }
        int dev = 0, cus = 0, per_cu = 0;
        (void)hipGetDevice(&dev); (void)hipDeviceGetAttribute(&cus, hipDeviceAttributeMultiprocessorCount, dev);
        if (hipFuncSetAttribute((const void*)fwd_megakernel, hipFuncAttributeMaxDynamicSharedMemorySize, LDS_BYTES) != hipSuccess) { fprintf(stderr, "kernel_launch: hipFuncSetAttribute failed\n"); grid = -1; return; }
        if (hipOccupancyMaxActiveBlocksPerMultiprocessor(&per_cu, (const void*)fwd_megakernel, 512, LDS_BYTES) != hipSuccess || per_cu < 1) { fprintf(stderr, "kernel_launch: occupancy query says %d blocks/CU\n", per_cu); per_cu = 1; }
        (void)hipGetLastError();
        grid = cus;
    }
    if (grid < 0) return;
    if (hipMemsetAsync(d_ws, 0, 16384, stream) != hipSuccess) { fprintf(stderr, "kernel_launch: hipMemsetAsync failed\n"); return; }
    Args a{};
    for (int i = 0; i < 26; ++i) a.in[i] = (const float*)d_in[i];
    a.out = (float*)d_out; a.ws = (unsigned char*)d_ws; a.ph_lo = 0; a.ph_hi = 17;
    void* args[] = {&a};
    hipError_t e = hipLaunchCooperativeKernel((const void*)fwd_megakernel, dim3(grid), dim3(512), args, LDS_BYTES, stream);
    if (e != hipSuccess) fprintf(stderr, "kernel_launch: cooperative launch failed: %s (grid %d)\n", hipGetErrorString(e), grid);
}
```

```cpp
#include <hip/hip_runtime.h>
#include <hip/hip_cooperative_groups.h>
#include <cstdio>
#include <cstdint>
namespace cg = cooperative_groups;

#define LAS __attribute__((address_space(3)))
typedef unsigned short bf16_t;
typedef short bf16x8 __attribute__((ext_vector_type(8)));
typedef float f32x4 __attribute__((ext_vector_type(4)));
typedef float f32x2 __attribute__((ext_vector_type(2)));
typedef unsigned u32x4 __attribute__((ext_vector_type(4)));
typedef unsigned u32x2 __attribute__((ext_vector_type(2)));

constexpr int DM = 2048, MP = 32768, MS = 512, MT = MP + MS;
constexpr int NIN = 10240, NZ = 4096, NGT = 6144, DFF = 5632, PLE = 256, NGU = 2 * DFF + DM;
constexpr float LN_EPS = 1e-5f, ALPHA = 1.41421356237f;
constexpr size_t O_YS = 67108864, O_NPP = O_YS + 1048576, O_NCP = O_NPP + 122880, O_NPS = O_NCP + 16384, O_NCS = O_NPS + 245760, O_SGV = O_NCS + 32768;
constexpr size_t MiB = 1u << 20;
constexpr int LD_ACT = DFF + 128;
constexpr size_t WS_WIN = 1 * MiB, WS_WBR = 41 * MiB, WS_WO = 49 * MiB, WS_WGU = 57 * MiB, WS_WDN = 109 * MiB, WS_WPE = 132 * MiB, WS_SGW = 133 * MiB;
constexpr size_t WS_PB0 = 134 * MiB, WS_PB1 = 150 * MiB + 512 * 1024;
static_assert(WS_WDN + (size_t)DM * LD_ACT * 2 <= WS_WPE && WS_PB0 + (size_t)MT * PLE * 2 <= WS_PB1 && WS_PB1 + (size_t)MT * PLE * 2 <= 167 * MiB, "ws map");
constexpr size_t WS_Z = 167 * MiB, WS_G = 427 * MiB, WS_Y = 817 * MiB;
constexpr size_t WS_T = 167 * MiB, WS_X1 = 297 * MiB, WS_ACT = 427 * MiB, WS_PE = 793 * MiB, WS_PART = 947 * MiB, WS_END = 979 * MiB;
static_assert(WS_ACT + (size_t)MT * LD_ACT * 2 <= WS_PE && WS_PE + (size_t)MT * DM * 2 <= WS_END, "ws map 2");
constexpr size_t DO_XB = 0, DO_MG = 130 * MiB;
constexpr int LDS_BYTES = 147456;

__device__ __forceinline__ unsigned cvt_pk_bf16(float lo, float hi) { unsigned r; asm volatile("v_cvt_pk_bf16_f32 %0, %1, %2" : "=v"(r) : "v"(lo), "v"(hi)); return r; }
__device__ __forceinline__ float bflo(unsigned w) { return __uint_as_float(w << 16); }
__device__ __forceinline__ float bfhi(unsigned w) { return __uint_as_float(w & 0xffff0000u); }
__device__ __forceinline__ float bf2f(bf16_t h) { return __uint_as_float(((unsigned)h) << 16); }
__device__ __forceinline__ float sigmoidf_(float x) { return __builtin_amdgcn_rcpf(1.0f + __builtin_amdgcn_exp2f(-1.44269504089f * x)); }
__device__ __forceinline__ float wave_sum(float v) {
#pragma unroll
    for (int o = 1; o < 64; o <<= 1) v += __shfl_xor(v, o);
    return v;
}
__device__ __forceinline__ f32x2 gelu_pk(f32x2 v) {
    const f32x2 av = __builtin_elementwise_abs(v), d = av * 0.2316418882f + 1.0f;
    f32x2 t; t.x = __builtin_amdgcn_rcpf(d.x); t.y = __builtin_amdgcn_rcpf(d.y);
    f32x2 q = t * 0.5307027145f + (-0.7265760135f); q = q * t + 0.7107068705f; q = q * t + (-0.142248368f); q = q * t + 0.127414796f; q = q * t;
    const f32x2 s = (v * v) * (-0.72134752044f);
    f32x2 e; e.x = __builtin_amdgcn_exp2f(s.x); e.y = __builtin_amdgcn_exp2f(s.y);
    const f32x2 m = v * (q * e), r = v - m;
    f32x2 o; o.x = v.x < 0.f ? m.x : r.x; o.y = v.y < 0.f ? m.y : r.y; return o;
}
__device__ __forceinline__ char* uptr(const void* p) { const unsigned long long v = (unsigned long long)p; const unsigned lo = __builtin_amdgcn_readfirstlane((unsigned)v), hi = __builtin_amdgcn_readfirstlane((unsigned)(v >> 32)); return (char*)(((unsigned long long)hi << 32) | lo); }
__device__ __forceinline__ void unpack8(const u32x4 v, float (&f)[8]) { f[0] = bflo(v.x); f[1] = bfhi(v.x); f[2] = bflo(v.y); f[3] = bfhi(v.y); f[4] = bflo(v.z); f[5] = bfhi(v.z); f[6] = bflo(v.w); f[7] = bfhi(v.w); }

namespace pg8 {
constexpr int BM = 256, BK = 64, HALF = 128, HTB = HALF * BK * 2, STAGE_BYTES = 8 * HTB, NXCD = 8, WGM = 4;
__device__ __forceinline__ int lds_byte(int r, int c) { const int st = (r >> 4) * 2 + (c >> 5), rr = r & 15, cc = c & 31, ob = rr * 64 + cc * 2; return st * 1024 + (ob ^ (((ob >> 9) & 1) << 5)); }
__device__ __forceinline__ void stage_rc(int b, int& R, int& C) { const int st = b / 1024, sb = b % 1024, swz = sb ^ (((sb >> 9) & 1) << 5); R = (st >> 1) * 16 + swz / 64; C = (st & 1) * 32 + (swz % 64) / 2; }
__device__ __forceinline__ int perm32(int rho) { const int n = rho >> 4, i = rho & 15; return 8 * (i >> 2) + 4 * n + (i & 3); }

struct Unit { int pm, pn, seg, part; };
struct Gemm { const bf16_t* A; const bf16_t* Bt; int ld; int nseg; unsigned ntpack, kopack; int nts; };
__device__ __forceinline__ unsigned pack3(int a, int b, int c) { return (unsigned)a | ((unsigned)b << 8) | ((unsigned)c << 16); }
__device__ __forceinline__ int seg_nt(const Gemm& g, int s) { return (int)((g.ntpack >> (8 * s)) & 0xffu); }
__device__ __forceinline__ int unit_nt(const Gemm& g, const Unit& u) { return u.part ? g.nts : seg_nt(g, u.seg); }
__device__ __forceinline__ int seg_koff(const Gemm& g, int s) { return BK * (int)((g.kopack >> (8 * s)) & 0xffu); }
__device__ __forceinline__ int unit_koff(const Gemm& g, const Unit& u) { return u.part ? BK * u.seg * g.nts : seg_koff(g, u.seg); }

struct Order {
    int nM, nN, nwg, G, c, nseg;
    int nsl, nslu, pm_sl;
    __device__ __forceinline__ void init(int nM_, int nN_, int G_, int c_, int nseg_) { nM = nM_; nN = nN_; nwg = nM * nN; G = G_; c = c_; nseg = nseg_; nsl = 1; nslu = 0; pm_sl = 0; }
    __device__ __forceinline__ void slices(int pm0, int ntiles_m, int nsl_) { pm_sl = pm0; nsl = nsl_; nslu = ntiles_m * nN * nsl_; }
    __device__ __forceinline__ bool next(int i, Unit& u) const {
        const int it = (nseg == 1) ? i : i / nseg; u.seg = i - it * nseg; u.part = 0;
        const long L = (long)it * G + c;
        if (L >= nwg) { const long s = L - nwg; if (s >= nslu) return false;
            const int tile = (int)s / nsl; u.seg = (int)s - tile * nsl; u.part = 1; u.pm = pm_sl + tile / nN; u.pn = tile % nN; return true; }
        int wgid = (int)L; { const int q = nwg / NXCD, r = nwg % NXCD, xcd = wgid % NXCD, off = wgid / NXCD; wgid = (xcd < r ? xcd * (q + 1) : r * (q + 1) + (xcd - r) * q) + off; }
        const int nig = WGM * nN, gid = wgid / nig, fm = gid * WGM, gsz = (nM - fm) < WGM ? (nM - fm) : WGM;
        u.pm = fm + ((wgid % nig) % gsz); u.pn = (wgid % nig) / gsz; return true;
    }
};

template <class Epi, bool ALIGN_EPI, bool SP2>
__device__ __forceinline__ void gemm_phase(LAS unsigned char* lds, const Gemm g, const Order& S, const Epi& E, const int tid) {
    const int wid = __builtin_amdgcn_readfirstlane(tid >> 6), lane = tid & 63, wr = wid >> 2, wc = wid & 3, fr = lane & 15, fq = lane >> 4;
    const int ld = g.ld;
    unsigned voffA[2], voffB[2];
#pragma unroll
    for (int i = 0; i < 2; ++i) { int R, C; stage_rc(tid * 16 + i * 8192, R, C); const int Rb = (R & ~31) + perm32(R & 31);
        voffA[i] = (unsigned)(R * ld + C) * 2u; voffB[i] = (unsigned)(Rb * ld + C) * 2u; }
    const size_t kstep = (size_t)(BK * 2);
    const size_t hstep = (size_t)HALF * ld * 2;
    const size_t tstep = 2 * hstep;
    const unsigned ldsw = (unsigned)wid * 1024u;
    const int aoff = lds_byte(wr * 64 + fr, fq * 8), boff = lds_byte(wc * 32 + fr, fq * 8);
#define PG8_SA(b, h) (((b) * 2 + (h)) * HTB)
#define PG8_SB(b, h) ((4 + (b) * 2 + (h)) * HTB)
#define PG8_STAGE(bufoff, gbase, voff) do { _Pragma("unroll") for (int _i = 0; _i < 2; ++_i) \
        __builtin_amdgcn_global_load_lds((const unsigned*)((const char*)(gbase) + (voff)[_i]), (LAS unsigned*)(lds + (bufoff) + ldsw + _i * 8192), 16, 0, 0); } while (0)
#define PG8_LDA(dst, b, h) do { _Pragma("unroll") for (int m = 0; m < 4; ++m) _Pragma("unroll") for (int k = 0; k < 2; ++k) dst[m][k] = *(const LAS bf16x8*)(lds + PG8_SA(b, h) + aoff + m * 2048 + k * 1024); } while (0)
#define PG8_LDB(dst, b, h) do { _Pragma("unroll") for (int n = 0; n < 2; ++n) _Pragma("unroll") for (int k = 0; k < 2; ++k) dst[n][k] = *(const LAS bf16x8*)(lds + PG8_SB(b, h) + boff + n * 2048 + k * 1024); } while (0)
#define PG8_MMA(ai, bj, At, Bt) do { __builtin_amdgcn_s_setprio(1); _Pragma("unroll") for (int m = 0; m < 4; ++m) _Pragma("unroll") for (int n = 0; n < 2; ++n) _Pragma("unroll") for (int k = 0; k < 2; ++k) \
        acc[ai][bj][m][n] = __builtin_amdgcn_mfma_f32_16x16x32_bf16(Bt[n][k], At[m][k], acc[ai][bj][m][n], 0, 0, 0); __builtin_amdgcn_s_setprio(0); } while (0)
#define PG8_WAIT_V(n) asm volatile("s_waitcnt vmcnt(" #n ")" ::: "memory")
#define PG8_WAIT_L(n) asm volatile("s_waitcnt lgkmcnt(" #n ")" ::: "memory")
#define PG8_BAR __builtin_amdgcn_s_barrier()
#define PG8_SCHED __builtin_amdgcn_sched_barrier(0)
    Unit cur, nxt; int ui = 0;
    if (!S.next(0, cur)) return;
    f32x4 acc[2][2][4][2];
#pragma unroll
    for (int a = 0; a < 2; ++a)
#pragma unroll
        for (int b = 0; b < 2; ++b)
#pragma unroll
            for (int m = 0; m < 4; ++m)
#pragma unroll
                for (int n = 0; n < 2; ++n) acc[a][b][m][n] = (f32x4){0.f, 0.f, 0.f, 0.f};
    bf16x8 At[4][2], B0[2][2], B1[2][2];
    int nt = unit_nt(g, cur);
    const char* cA = (const char*)g.A + (size_t)cur.pm * tstep + (size_t)unit_koff(g, cur) * 2; const char* cB = (const char*)g.Bt + (size_t)cur.pn * tstep + (size_t)unit_koff(g, cur) * 2;
    if constexpr (SP2) {
        PG8_STAGE(PG8_SB(0, 0), cB, voffB); PG8_STAGE(PG8_SB(0, 1), cB + hstep, voffB); PG8_STAGE(PG8_SA(0, 0), cA, voffA); PG8_STAGE(PG8_SA(0, 1), cA + hstep, voffA);
        if (wr == 1) PG8_BAR;
        PG8_WAIT_V(2); PG8_BAR;
        PG8_STAGE(PG8_SB(1, 0), cB + kstep, voffB); PG8_STAGE(PG8_SA(1, 0), cA + kstep, voffA); PG8_STAGE(PG8_SB(1, 1), cB + hstep + kstep, voffB);
        PG8_WAIT_V(6); PG8_BAR;
    } else {
        PG8_STAGE(PG8_SB(0, 0), cB, voffB); PG8_STAGE(PG8_SA(0, 0), cA, voffA); PG8_STAGE(PG8_SB(0, 1), cB + hstep, voffB); PG8_STAGE(PG8_SA(0, 1), cA + hstep, voffA);
        if (wr == 1) PG8_BAR;
        PG8_WAIT_V(4); PG8_BAR;
        PG8_STAGE(PG8_SB(1, 0), cB + kstep, voffB); PG8_STAGE(PG8_SA(1, 0), cA + kstep, voffA); PG8_STAGE(PG8_SB(1, 1), cB + hstep + kstep, voffB);
        PG8_WAIT_V(6); PG8_BAR;
    }
    for (;;) {
        const bool has_next = S.next(ui + 1, nxt);
        const char* nA = has_next ? (const char*)g.A + (size_t)nxt.pm * tstep + (size_t)unit_koff(g, nxt) * 2 : cA;
        const char* nB = has_next ? (const char*)g.Bt + (size_t)nxt.pn * tstep + (size_t)unit_koff(g, nxt) * 2 : cB;
        for (int t = 0; t < nt; t += 2) {
            const bool last = (t == nt - 2);
            const char* a1 = cA + (size_t)(t + 1) * kstep;
            const char* a2 = last ? nA : cA + (size_t)(t + 2) * kstep; const char* b2 = last ? nB : cB + (size_t)(t + 2) * kstep;
            const char* a3 = a2 + kstep; const char* b3 = b2 + kstep;
            if constexpr (SP2) {
            PG8_LDB(B0, 0, 0); PG8_LDB(B1, 0, 1); PG8_SCHED; PG8_LDA(At, 0, 0); PG8_STAGE(PG8_SA(1, 1), a1 + hstep, voffA);
            PG8_WAIT_V(8); PG8_WAIT_L(0); PG8_BAR; PG8_MMA(0, 0, At, B0); PG8_MMA(0, 1, At, B1); PG8_BAR; PG8_SCHED;
            PG8_LDA(At, 0, 1); PG8_STAGE(PG8_SB(0, 0), b2, voffB); PG8_STAGE(PG8_SB(0, 1), b2 + hstep, voffB); PG8_STAGE(PG8_SA(0, 0), a2, voffA);
            PG8_WAIT_V(8); PG8_WAIT_L(0); PG8_BAR; PG8_MMA(1, 0, At, B0); PG8_MMA(1, 1, At, B1); PG8_BAR; PG8_SCHED;
            PG8_LDB(B0, 1, 0); PG8_LDB(B1, 1, 1); PG8_SCHED; PG8_LDA(At, 1, 0); PG8_STAGE(PG8_SA(0, 1), a2 + hstep, voffA);
            PG8_WAIT_V(8); PG8_WAIT_L(0); PG8_BAR; PG8_MMA(0, 0, At, B0); PG8_MMA(0, 1, At, B1); PG8_BAR; PG8_SCHED;
            PG8_LDA(At, 1, 1); PG8_STAGE(PG8_SB(1, 0), b3, voffB); PG8_STAGE(PG8_SB(1, 1), b3 + hstep, voffB); PG8_STAGE(PG8_SA(1, 0), a3, voffA);
            PG8_WAIT_V(8); PG8_WAIT_L(0); PG8_BAR; PG8_MMA(1, 0, At, B0); PG8_MMA(1, 1, At, B1); PG8_BAR; PG8_SCHED;
            } else {
            PG8_LDB(B0, 0, 0); PG8_SCHED; PG8_LDA(At, 0, 0); PG8_STAGE(PG8_SA(1, 1), a1 + hstep, voffA);
            PG8_WAIT_L(8); PG8_BAR; PG8_WAIT_L(0); PG8_MMA(0, 0, At, B0); PG8_BAR; PG8_SCHED;
            PG8_LDB(B1, 0, 1); PG8_STAGE(PG8_SB(0, 0), b2, voffB);
            PG8_BAR; PG8_WAIT_L(0); PG8_MMA(0, 1, At, B1); PG8_BAR;
            PG8_LDA(At, 0, 1); PG8_STAGE(PG8_SA(0, 0), a2, voffA);
            PG8_BAR; PG8_WAIT_L(0); PG8_MMA(1, 0, At, B0); PG8_BAR; PG8_SCHED;
            PG8_STAGE(PG8_SB(0, 1), b2 + hstep, voffB);
            PG8_WAIT_V(6); PG8_BAR; PG8_MMA(1, 1, At, B1); PG8_BAR;
            PG8_LDB(B0, 1, 0); PG8_SCHED; PG8_LDA(At, 1, 0); PG8_STAGE(PG8_SA(0, 1), a2 + hstep, voffA);
            PG8_WAIT_L(8); PG8_BAR; PG8_WAIT_L(0); PG8_MMA(0, 0, At, B0); PG8_BAR; PG8_SCHED;
            PG8_LDB(B1, 1, 1); PG8_STAGE(PG8_SB(1, 0), b3, voffB);
            PG8_BAR; PG8_WAIT_L(0); PG8_MMA(0, 1, At, B1); PG8_BAR;
            PG8_LDA(At, 1, 1); PG8_STAGE(PG8_SA(1, 0), a3, voffA);
            PG8_BAR; PG8_WAIT_L(0); PG8_MMA(1, 0, At, B0); PG8_BAR; PG8_SCHED;
            PG8_STAGE(PG8_SB(1, 1), b3 + hstep, voffB);
            PG8_WAIT_V(6); PG8_BAR; PG8_MMA(1, 1, At, B1); PG8_BAR;
            }
        }
        if constexpr (ALIGN_EPI) { if (wr == 0) PG8_BAR; }
        const bool keep = E(acc, cur, wr, wc, fr, fq);
        if (!has_next) break;
        if (!keep) {
#pragma unroll
        for (int a = 0; a < 2; ++a)
#pragma unroll
            for (int b = 0; b < 2; ++b)
#pragma unroll
                for (int m = 0; m < 4; ++m)
#pragma unroll
                    for (int n = 0; n < 2; ++n) acc[a][b][m][n] = (f32x4){0.f, 0.f, 0.f, 0.f};
        }
        cur = nxt; cA = nA; cB = nB; nt = unit_nt(g, cur); ++ui;
        if constexpr (ALIGN_EPI) { if (wr == 1) PG8_BAR; }
    }
    PG8_WAIT_V(0);
    if constexpr (!ALIGN_EPI) { if (wr == 0) PG8_BAR; }
    PG8_BAR;
#undef PG8_SA
#undef PG8_SB
#undef PG8_STAGE
#undef PG8_LDA
#undef PG8_LDB
#undef PG8_MMA
#undef PG8_WAIT_V
#undef PG8_WAIT_L
#undef PG8_BAR
#undef PG8_SCHED
}

typedef f32x4 AccT[2][2][4][2];
#define EPI_ROWS_BEGIN _Pragma("unroll") for (int ai = 0; ai < 2; ++ai) _Pragma("unroll") for (int m = 0; m < 4; ++m) { const int row = row0 + ai * HALF + m * 16;
#define EPI_ROWS_END asm volatile("" ::: "memory"); }
__device__ __forceinline__ u32x4 pack8(const f32x4 v0, const f32x4 v1) { u32x4 w; w.x = cvt_pk_bf16(v0[0], v0[1]); w.y = cvt_pk_bf16(v0[2], v0[3]); w.z = cvt_pk_bf16(v1[0], v1[1]); w.w = cvt_pk_bf16(v1[2], v1[3]); return w; }

struct EpiIn {
    bf16_t* Z; bf16_t* G;
    __device__ __forceinline__ bool operator()(AccT& acc, const Unit& u, int wr, int wc, int fr, int fq) const {
        bf16_t* base; int ldc, colt, mode;
        if (u.pn < 16) { base = Z; ldc = NZ; colt = u.pn * BM; mode = (u.pn >= 2 && u.pn < 10) ? 1 : 0; } else { base = G; ldc = NGT; colt = (u.pn - 16) * BM; mode = 2; }
        const int row0 = u.pm * BM + wr * 64 + fr, col0 = colt + wc * 32 + 8 * fq;
        EPI_ROWS_BEGIN
            bf16_t* rowp = base + (size_t)row * ldc + col0;
#pragma unroll
            for (int bj = 0; bj < 2; ++bj) { f32x4 v0 = acc[ai][bj][m][0], v1 = acc[ai][bj][m][1];
                if (mode == 1) { f32x2 a = gelu_pk((f32x2){v0[0], v0[1]}), b = gelu_pk((f32x2){v0[2], v0[3]}), c = gelu_pk((f32x2){v1[0], v1[1]}), d = gelu_pk((f32x2){v1[2], v1[3]});
                    v0 = (f32x4){a.x, a.y, b.x, b.y}; v1 = (f32x4){c.x, c.y, d.x, d.y}; }
                else if (mode == 2) {
#pragma unroll
                    for (int j = 0; j < 4; ++j) { v0[j] = fminf(1.0f + __builtin_amdgcn_exp2f(-1.44269504089f * v0[j]), 1e30f); v1[j] = fminf(1.0f + __builtin_amdgcn_exp2f(-1.44269504089f * v1[j]), 1e30f); } }
                *(u32x4*)(rowp + bj * HALF) = pack8(v0, v1); }
        EPI_ROWS_END
        return false;
    }
};
struct EpiStore {
    bf16_t* O; int ldc;
    __device__ __forceinline__ bool operator()(AccT& acc, const Unit& u, int wr, int wc, int fr, int fq) const {
        const int row0 = u.pm * BM + wr * 64 + fr, col0 = u.pn * BM + wc * 32 + 8 * fq;
        EPI_ROWS_BEGIN
            bf16_t* rowp = O + (size_t)row * ldc + col0;
#pragma unroll
            for (int bj = 0; bj < 2; ++bj) *(u32x4*)(rowp + bj * HALF) = pack8(acc[ai][bj][m][0], acc[ai][bj][m][1]);
        EPI_ROWS_END
        return false;
    }
};
struct EpiBr {
    const bf16_t* G; bf16_t* MG;
    __device__ __forceinline__ bool operator()(AccT& acc, const Unit& u, int wr, int wc, int fr, int fq) const {
        const int row0 = u.pm * BM + wr * 64 + fr, col0 = u.pn * BM + wc * 32 + 8 * fq;
        if (u.seg < 2) {
#pragma unroll
            for (int ai = 0; ai < 2; ++ai) {
                u32x4 wa[4][2], wb[4][2];
#pragma unroll
                for (int m = 0; m < 4; ++m) { const bf16_t* gp = G + (size_t)(row0 + ai * HALF + m * 16) * NGT + u.seg * DM + col0;
#pragma unroll
                    for (int bj = 0; bj < 2; ++bj) { wa[m][bj] = *(const u32x4*)(gp + bj * HALF); wb[m][bj] = *(const u32x4*)(gp + DM + bj * HALF); } }
#pragma unroll
                for (int m = 0; m < 4; ++m)
#pragma unroll
                    for (int bj = 0; bj < 2; ++bj) { float fa[8], fb[8]; unpack8(wa[m][bj], fa); unpack8(wb[m][bj], fb);
#pragma unroll
                        for (int j = 0; j < 4; ++j) { acc[ai][bj][m][0][j] *= fb[j] * __builtin_amdgcn_rcpf(fa[j]); acc[ai][bj][m][1][j] *= fb[4 + j] * __builtin_amdgcn_rcpf(fa[4 + j]); } }
                asm volatile("" ::: "memory");
            }
            return true;
        }
#pragma unroll
        for (int ai = 0; ai < 2; ++ai) {
            u32x4 wa[4][2];
#pragma unroll
            for (int m = 0; m < 4; ++m) { const bf16_t* gp = G + (size_t)(row0 + ai * HALF + m * 16) * NGT + 2 * DM + col0;
#pragma unroll
                for (int bj = 0; bj < 2; ++bj) wa[m][bj] = *(const u32x4*)(gp + bj * HALF); }
#pragma unroll
            for (int m = 0; m < 4; ++m) { bf16_t* op = MG + (size_t)(row0 + ai * HALF + m * 16) * DM + col0;
#pragma unroll
                for (int bj = 0; bj < 2; ++bj) { float fa[8]; unpack8(wa[m][bj], fa);
                    f32x4 v0 = acc[ai][bj][m][0], v1 = acc[ai][bj][m][1];
#pragma unroll
                    for (int j = 0; j < 4; ++j) { v0[j] *= __builtin_amdgcn_rcpf(fa[j]); v1[j] *= __builtin_amdgcn_rcpf(fa[4 + j]); }
                    *(u32x4*)(op + bj * HALF) = pack8(v0, v1); } }
            asm volatile("" ::: "memory");
        }
        return false;
    }
};
struct EpiRes {
    const bf16_t* R; const bf16_t* P; bf16_t* T; bf16_t* PART;
    __device__ __forceinline__ bool operator()(AccT& acc, const Unit& u, int wr, int wc, int fr, int fq) const {
        const int row0 = u.pm * BM + wr * 64 + fr, col0 = u.pn * BM + wc * 32 + 8 * fq;
        if (u.part) {
            EPI_ROWS_BEGIN
                bf16_t* pp = PART + ((size_t)u.seg * MS + (row - MP)) * DM + col0;
#pragma unroll
                for (int bj = 0; bj < 2; ++bj) *(u32x4*)(pp + bj * HALF) = pack8(acc[ai][bj][m][0], acc[ai][bj][m][1]);
            EPI_ROWS_END
            return false;
        }
#pragma unroll
        for (int ai = 0; ai < 2; ++ai) {
            u32x4 wrr[4][2], wpp[4][2];
#pragma unroll
            for (int m = 0; m < 4; ++m) { const size_t off = (size_t)(row0 + ai * HALF + m * 16) * DM + col0;
#pragma unroll
                for (int bj = 0; bj < 2; ++bj) { wrr[m][bj] = *(const u32x4*)(R + off + bj * HALF); if (P) wpp[m][bj] = *(const u32x4*)(P + off + bj * HALF); } }
#pragma unroll
            for (int m = 0; m < 4; ++m) { const size_t off = (size_t)(row0 + ai * HALF + m * 16) * DM + col0;
#pragma unroll
                for (int bj = 0; bj < 2; ++bj) { float fr_[8]; unpack8(wrr[m][bj], fr_);
                    f32x4 v0 = acc[ai][bj][m][0], v1 = acc[ai][bj][m][1];
#pragma unroll
                    for (int j = 0; j < 4; ++j) { v0[j] += ALPHA * fr_[j]; v1[j] += ALPHA * fr_[4 + j]; }
                    if (P) { float fp[8]; unpack8(wpp[m][bj], fp);
#pragma unroll
                        for (int j = 0; j < 4; ++j) { v0[j] += fp[j]; v1[j] += fp[4 + j]; } }
                    *(u32x4*)(T + off + bj * HALF) = pack8(v0, v1); } }
            asm volatile("" ::: "memory");
        }
        return false;
    }
};
struct EpiGu {
    bf16_t* ACT; bf16_t* PE;
    __device__ __forceinline__ bool operator()(AccT& acc, const Unit& u, int wr, int wc, int fr, int fq) const {
        const int row0 = u.pm * BM + wr * 64 + fr;
        if (u.pn < 44) {
            const int col0 = u.pn * HALF + wc * 32 + 8 * fq;
            EPI_ROWS_BEGIN
                f32x4 v0, v1;
#pragma unroll
                for (int j = 0; j < 4; ++j) { const float g0 = acc[ai][0][m][0][j], g1 = acc[ai][0][m][1][j];
                    v0[j] = g0 * sigmoidf_(g0) * acc[ai][1][m][0][j]; v1[j] = g1 * sigmoidf_(g1) * acc[ai][1][m][1][j]; }
                *(u32x4*)(ACT + (size_t)row * LD_ACT + col0) = pack8(v0, v1);
            EPI_ROWS_END
        } else {
            const int col0 = (u.pn - 44) * BM + wc * 32 + 8 * fq;
#pragma unroll
            for (int ai = 0; ai < 2; ++ai) {
                u32x4 wpp[4][2];
#pragma unroll
                for (int m = 0; m < 4; ++m) { const bf16_t* pp = PE + (size_t)(row0 + ai * HALF + m * 16) * DM + col0;
#pragma unroll
                    for (int bj = 0; bj < 2; ++bj) wpp[m][bj] = *(const u32x4*)(pp + bj * HALF); }
#pragma unroll
                for (int m = 0; m < 4; ++m) { bf16_t* pp = PE + (size_t)(row0 + ai * HALF + m * 16) * DM + col0;
#pragma unroll
                    for (int bj = 0; bj < 2; ++bj) { float fp[8]; unpack8(wpp[m][bj], fp);
                        f32x4 v0, v1;
#pragma unroll
                        for (int j = 0; j < 4; ++j) { v0[j] = sigmoidf_(acc[ai][bj][m][0][j]) * fp[j]; v1[j] = sigmoidf_(acc[ai][bj][m][1][j]) * fp[4 + j]; }
                        *(u32x4*)(pp + bj * HALF) = pack8(v0, v1); } }
                asm volatile("" ::: "memory");
            }
        }
        return false;
    }
};
}


#define XB_TMO      128
#define XB_XCNT(j)  (256  + 64 * (j))
#define XB_XSUB(j)  (1280 + 64 * (j))
#define XB_XGEN(j)  (2304 + 64 * (j))
#define XB_TOP      3328
#define XB_TOPGEN   3392
#define XCD_BAR_WORDS 3456
#define XB_SPIN_CAP (1u << 20)
__device__ __forceinline__ unsigned xb_ld(unsigned* p)              { return __hip_atomic_load(p, __ATOMIC_RELAXED, __HIP_MEMORY_SCOPE_AGENT); }
__device__ __forceinline__ unsigned xb_add(unsigned* p, unsigned v) { return __hip_atomic_fetch_add(p, v, __ATOMIC_RELAXED, __HIP_MEMORY_SCOPE_AGENT); }
__device__ __forceinline__ unsigned xb_xcc_id() { return (unsigned)__builtin_amdgcn_s_getreg((3 << 11) | 20) & 0xFu; }
#define XB_SPIN(cond, bar) do { unsigned _sp = 0; while (cond) { __builtin_amdgcn_s_sleep(1); \
    if ((++_sp & 255u) == 0u) { if (xb_ld(&(bar)[XB_TMO])) break; if (_sp > XB_SPIN_CAP) { atomicAdd(&(bar)[XB_TMO], 1u); break; } } } } while (0)
struct XcdBarrier { unsigned* bar; unsigned x; volatile LAS unsigned* st; };
__device__ __forceinline__ XcdBarrier xcd_barrier_post(unsigned* bar, volatile LAS unsigned* st) {
    XcdBarrier b; b.bar = bar; b.x = xb_xcc_id(); b.st = st;
    if (threadIdx.x == 0) (void)xb_add(&bar[XB_XCNT(b.x)], 1u);
    return b;
}
__device__ __forceinline__ void xcd_barrier_complete(unsigned* bar, unsigned x, unsigned& nloc, unsigned& nx) {
    const unsigned G = gridDim.x * gridDim.y * gridDim.z;
    unsigned sum, cnt, mine, sp = 0u;
    for (;;) {
        sum = 0u; cnt = 0u; mine = 0u;
#pragma unroll
        for (unsigned j = 0; j < 16; ++j) { const unsigned c = xb_ld(&bar[XB_XCNT(j)]); sum += c; cnt += (c > 0u) ? 1u : 0u; mine = (j == x) ? c : mine; }
        if (sum == G) break;
        __builtin_amdgcn_s_sleep(1);
        if ((++sp & 255u) == 0u) { if (xb_ld(&bar[XB_TMO])) break; if (sp > XB_SPIN_CAP) { atomicAdd(&bar[XB_TMO], 1u); break; } }
    }
    nloc = mine > 0u ? mine : 1u; nx = cnt > 0u ? cnt : 1u;
}
__device__ __forceinline__ void xcd_barrier(const XcdBarrier& b) {
    asm volatile("s_waitcnt vmcnt(0)" ::: "memory");
    __syncthreads();
    if (threadIdx.x == 0) {
        unsigned* bar = b.bar;
        __builtin_amdgcn_s_waitcnt(0);
        unsigned nloc = b.st[0], nx = b.st[1];
        if (nloc == 0u) { xcd_barrier_complete(bar, b.x, nloc, nx); b.st[0] = nloc; b.st[1] = nx; }
        const unsigned old = xb_add(&bar[XB_XSUB(b.x)], 1u);
        const unsigned gen = old / nloc;
        if (old + 1u == (gen + 1u) * nloc) {
            __builtin_amdgcn_fence(__ATOMIC_RELEASE, "agent");
            asm volatile("s_waitcnt vmcnt(0)" ::: "memory");
            const unsigned og = xb_add(&bar[XB_TOP], 1u);
            const unsigned tg = og / nx;
            if (og + 1u == (tg + 1u) * nx) xb_add(&bar[XB_TOPGEN], 1u);
            else XB_SPIN(xb_ld(&bar[XB_TOPGEN]) == tg, bar);
            __builtin_amdgcn_fence(__ATOMIC_ACQUIRE, "agent");
            xb_add(&bar[XB_XGEN(b.x)], 1u);
            asm volatile("s_waitcnt vmcnt(0)" ::: "memory");
        } else {
            XB_SPIN(xb_ld(&bar[XB_XGEN(b.x)]) == gen, bar);
            __builtin_amdgcn_fence(__ATOMIC_ACQUIRE, "agent");
            asm volatile("s_waitcnt vmcnt(0)" ::: "memory");
        }
    }
    __syncthreads();
}

struct Args { const float* in[26]; float* out; unsigned char* ws; int ph_lo, ph_hi; };
enum { I_XP = 0, I_XS, I_SPOOL, I_SCONV, I_PP, I_PS, I_WIN, I_POOLW, I_POOLS, I_SLNG, I_SLNB, I_SGUW, I_SGUB, I_CONVW, I_WBRA, I_WBRB, I_WBRC, I_WO, I_LN1G, I_LN1B, I_WGU, I_WDN, I_WPE, I_WPEG, I_LN2G, I_LN2B };

struct TrP { const float* W; bf16_t* WT; int N, ldt, koff, row_off, mode, r; };
__device__ __forceinline__ void tr_load(const TrP& p, int lane, float (&v)[32]) {
    const int nblk = p.N / 32, kb = p.r / nblk, nb = p.r - kb * nblk, k0 = 64 * kb, n0 = 32 * nb;
    const float* src = p.W + (size_t)(k0 + (lane >> 5)) * p.N + n0 + (lane & 31);
#pragma unroll
    for (int i = 0; i < 32; ++i) v[i] = src[(size_t)(2 * i) * p.N];
}
__device__ __forceinline__ void tr_store(const TrP& p, LAS float* scr, int lane, const float (&v)[32]) {
    const int nblk = p.N / 32, kb = p.r / nblk, nb = p.r - kb * nblk, k0 = 64 * kb, n0 = 32 * nb;
#pragma unroll
    for (int i = 0; i < 32; ++i) { const int kk = 2 * i + (lane >> 5); scr[kk * 33 + (lane & 31)] = v[i]; }
    asm volatile("s_waitcnt lgkmcnt(0)" ::: "memory");
    const int c = lane & 7;
    int d0 = n0;
    if (p.mode == 1) { const int half = n0 >= DFF ? 1 : 0, ff = n0 - half * DFF; d0 = (ff >> 7) * 256 + half * 128 + (ff & 127); }
    d0 += p.row_off;
#pragma unroll
    for (int j = 0; j < 4; ++j) { const int n = (lane >> 3) + 8 * j; const LAS float* sp = scr + (8 * c) * 33 + n;
        u32x4 o; o.x = cvt_pk_bf16(sp[0 * 33], sp[1 * 33]); o.y = cvt_pk_bf16(sp[2 * 33], sp[3 * 33]); o.z = cvt_pk_bf16(sp[4 * 33], sp[5 * 33]); o.w = cvt_pk_bf16(sp[6 * 33], sp[7 * 33]);
        *(u32x4*)(p.WT + (size_t)(d0 + n) * p.ldt + p.koff + k0 + 8 * c) = o; }
    asm volatile("s_waitcnt lgkmcnt(0)" ::: "memory");
}

__device__ __forceinline__ void convert_weights(const Args& a, int l, LAS unsigned char* lds, int gw, int NGW, int wave, int lane) {
    unsigned char* ws = a.ws;
    LAS float* scr = (LAS float*)(lds + wave * 8704);
    constexpr int I0 = 32 * 320, I1 = I0 + 16 * 64, I2 = I1 + 8 * 64, I3 = I2 + 32 * 64, I4 = I3 + 32 * 352, I5 = I4 + 32 * 64, I6 = I5 + 88 * 64, I7 = I6 + 4 * 64;
#define TR_PARAMS(P, it) do { (P).koff = 0; (P).row_off = 0; (P).mode = 0; \
        if ((it) < I0)      { (P).r = (it);      (P).W = a.in[I_WIN] + (size_t)l * DM * NIN;      (P).N = NIN;     (P).WT = (bf16_t*)(ws + WS_WIN); (P).ldt = DM; } \
        else if ((it) < I1) { (P).r = (it) - I0; (P).W = a.in[I_WBRB] + (size_t)l * 1024 * DM;    (P).N = DM;      (P).WT = (bf16_t*)(ws + WS_WBR); (P).ldt = DM; (P).koff = 512; } \
        else if ((it) < I2) { (P).r = (it) - I1; (P).W = a.in[I_WBRC] + (size_t)l * 512 * DM;     (P).N = DM;      (P).WT = (bf16_t*)(ws + WS_WBR); (P).ldt = DM; (P).koff = 1536; } \
        else if ((it) < I3) { (P).r = (it) - I2; (P).W = a.in[I_WO] + (size_t)l * DM * DM;        (P).N = DM;      (P).WT = (bf16_t*)(ws + WS_WO);  (P).ldt = DM; } \
        else if ((it) < I4) { (P).r = (it) - I3; (P).W = a.in[I_WGU] + (size_t)l * DM * 2 * DFF;  (P).N = 2 * DFF; (P).WT = (bf16_t*)(ws + WS_WGU); (P).ldt = DM; (P).mode = 1; } \
        else if ((it) < I5) { (P).r = (it) - I4; (P).W = a.in[I_WPEG] + (size_t)l * DM * DM;      (P).N = DM;      (P).WT = (bf16_t*)(ws + WS_WGU); (P).ldt = DM; (P).row_off = 2 * DFF; } \
        else if ((it) < I6) { (P).r = (it) - I5; (P).W = a.in[I_WDN] + (size_t)l * DFF * DM;      (P).N = DM;      (P).WT = (bf16_t*)(ws + WS_WDN); (P).ldt = LD_ACT; } \
        else                { (P).r = (it) - I6; (P).W = a.in[I_WPE] + (size_t)l * PLE * DM;      (P).N = DM;      (P).WT = (bf16_t*)(ws + WS_WPE); (P).ldt = PLE; } } while (0)
    {
        int it = gw; TrP P; float v[32];
        if (it < I7) { TR_PARAMS(P, it); tr_load(P, lane, v); }
        while (it < I7) {
            const int itn = it + NGW; const bool hn = itn < I7;
            TrP Pn = P; float vn[32];
            if (hn) { TR_PARAMS(Pn, itn); tr_load(Pn, lane, vn); }
            tr_store(P, scr, lane, v);
            if (hn) { P = Pn;
#pragma unroll
                for (int i = 0; i < 32; ++i) v[i] = vn[i]; }
            it = itn;
        }
    }
#undef TR_PARAMS
    for (int r = gw; r < 4096; r += NGW) {
        const int g = r >> 10, cb = (r >> 5) & 31, nb = r & 31, n = nb * 64 + lane;
        const float* pw = a.in[I_POOLW] + ((size_t)(l * 4 + g) * 128 + cb * 4) * 128; const float* sc = a.in[I_POOLS] + l * 512 + g * 128;
        const float* wa = a.in[I_WBRA] + (size_t)l * 512 * DM + (size_t)(g * 128) * DM + n;
        float s0 = 0.f, s1 = 0.f, s2 = 0.f, s3 = 0.f;
        for (int d = 0; d < 128; ++d) { const float wv = wa[(size_t)d * DM] * sc[d]; s0 += pw[d] * wv; s1 += pw[128 + d] * wv; s2 += pw[256 + d] * wv; s3 += pw[384 + d] * wv; }
        u32x2 o; o.x = cvt_pk_bf16(s0, s1); o.y = cvt_pk_bf16(s2, s3);
        *(u32x2*)((bf16_t*)(ws + WS_WBR) + (size_t)n * DM + g * 128 + cb * 4) = o;
    }
    const float* sw = a.in[I_SGUW] + (size_t)l * 131072; bf16_t* so = (bf16_t*)(ws + WS_SGW);
    for (int i = gw * 64 + lane; i < 131072 / 2; i += NGW * 64) { const int e = 2 * i, t = (e >> 7) & 127, s = e & 127;
        const float v0 = s <= t ? sw[e] : 0.f, v1 = (s + 1) <= t ? sw[e + 1] : 0.f; ((unsigned*)so)[i] = cvt_pk_bf16(v0, v1); }
}

__device__ __forceinline__ void convert_rows(const float* srcA, size_t nA8, const float* srcB, size_t n8, bf16_t* dst, int gtid, int NT) {
    for (size_t i0 = gtid; i0 < n8; i0 += (size_t)4 * NT) {
        f32x4 v[4][2];
#pragma unroll
        for (int u = 0; u < 4; ++u) { const size_t i = i0 + (size_t)u * NT; if (i < n8) { const float* s = i < nA8 ? srcA + i * 8 : srcB + (i - nA8) * 8; v[u][0] = *(const f32x4*)s; v[u][1] = *(const f32x4*)(s + 4); } }
#pragma unroll
        for (int u = 0; u < 4; ++u) { const size_t i = i0 + (size_t)u * NT; if (i < n8) *(u32x4*)(dst + i * 8) = pg8::pack8(v[u][0], v[u][1]); }
    }
}

__device__ __forceinline__ void ln_finish(float (&x)[32], float s, int row, const float* gam, const float* bet, bf16_t* outb, float* outf, int lane) {
    const float mean = wave_sum(s) * (1.0f / DM); float q = 0.f;
#pragma unroll
    for (int k = 0; k < 32; ++k) { x[k] -= mean; q += x[k] * x[k]; }
    const float rstd = rsqrtf(wave_sum(q) * (1.0f / DM) + LN_EPS);
#pragma unroll
    for (int j = 0; j < 4; ++j) { const int c = j * 512 + lane * 8;
        const f32x4 g0 = *(const f32x4*)(gam + c), g1 = *(const f32x4*)(gam + c + 4), b0 = *(const f32x4*)(bet + c), b1 = *(const f32x4*)(bet + c + 4);
        f32x4 y0, y1;
#pragma unroll
        for (int k = 0; k < 4; ++k) { y0[k] = x[j * 8 + k] * rstd * g0[k] + b0[k]; y1[k] = x[j * 8 + 4 + k] * rstd * g1[k] + b1[k]; }
        if (outf) { *(f32x4*)(outf + (size_t)row * DM + c) = y0; *(f32x4*)(outf + (size_t)row * DM + c + 4) = y1; }
        else *(u32x4*)(outb + (size_t)row * DM + c) = pg8::pack8(y0, y1); }
}
__device__ __forceinline__ void ln_phase(const bf16_t* T, const bf16_t* R, const bf16_t* P, const bf16_t* PART, int nsl, const float* gam, const float* bet, bf16_t* outb, float* outf, int gw, int NGW, int lane) {
    for (int base = gw; base < MP; base += 4 * NGW) {
        u32x4 w[4][4];
#pragma unroll
        for (int u = 0; u < 4; ++u) { const int row = base + u * NGW; if (row < MP) { const bf16_t* tp = T + (size_t)row * DM + lane * 8;
#pragma unroll
            for (int j = 0; j < 4; ++j) w[u][j] = *(const u32x4*)(tp + j * 512); } }
#pragma unroll
        for (int u = 0; u < 4; ++u) { const int row = base + u * NGW; if (row < MP) {
            float x[32]; float s = 0.f;
#pragma unroll
            for (int j = 0; j < 4; ++j) { float f[8]; unpack8(w[u][j], f);
#pragma unroll
                for (int k = 0; k < 8; ++k) { x[j * 8 + k] = f[k]; s += f[k]; } }
            ln_finish(x, s, row, gam, bet, outb, outf, lane);
        } }
    }
    const int G_ = NGW >> 3, bid_ = gw >> 3, wv_ = gw & 7;
    for (int sr = wv_ * G_ + bid_; sr < MS; sr += NGW) {
        const int row = MP + sr;
        float x[32];
        { const bf16_t* rp = R + (size_t)row * DM + lane * 8; u32x4 w[4];
#pragma unroll
          for (int j = 0; j < 4; ++j) w[j] = *(const u32x4*)(rp + j * 512);
#pragma unroll
          for (int j = 0; j < 4; ++j) { float f[8]; unpack8(w[j], f);
#pragma unroll
              for (int k = 0; k < 8; ++k) x[j * 8 + k] = ALPHA * f[k]; } }
        if (P) { const bf16_t* pp = P + (size_t)row * DM + lane * 8; u32x4 w[4];
#pragma unroll
          for (int j = 0; j < 4; ++j) w[j] = *(const u32x4*)(pp + j * 512);
#pragma unroll
          for (int j = 0; j < 4; ++j) { float f[8]; unpack8(w[j], f);
#pragma unroll
              for (int k = 0; k < 8; ++k) x[j * 8 + k] += f[k]; } }
        for (int sl0 = 0; sl0 < nsl; sl0 += 6) { u32x4 w[6][4];
#pragma unroll
          for (int q = 0; q < 6; ++q) if (sl0 + q < nsl) { const bf16_t* pp = PART + ((size_t)(sl0 + q) * MS + sr) * DM + lane * 8;
#pragma unroll
              for (int j = 0; j < 4; ++j) w[q][j] = *(const u32x4*)(pp + j * 512); }
#pragma unroll
          for (int q = 0; q < 6; ++q) if (sl0 + q < nsl) {
#pragma unroll
              for (int j = 0; j < 4; ++j) { float f[8]; unpack8(w[q][j], f);
#pragma unroll
                  for (int k = 0; k < 8; ++k) x[j * 8 + k] += f[k]; } } }
        float s = 0.f;
#pragma unroll
        for (int k = 0; k < 32; ++k) s += x[k];
        ln_finish(x, s, row, gam, bet, outb, outf, lane);
    }
}

__device__ __forceinline__ void mix_phase(const Args& a, int l, LAS unsigned char* lds, const bf16_t* __restrict__ Z, bf16_t* __restrict__ Y, const int tid, const int bid) {
    const int lane = tid & 63, wave = __builtin_amdgcn_readfirstlane(tid >> 6), g = wave, quad = lane >> 4, l15 = lane & 15;
    LAS f32x2* stats = (LAS f32x2*)lds;
    const bf16_t* sguw = (const bf16_t*)(a.ws + WS_SGW);
    float* __restrict__ out = a.out;
    for (int item = bid; item < 272; item += gridDim.x) {
        const bool sample = item >= 256;
        const int sb = item - 256, b = item >> 5;
        const int row0 = sample ? MP + sb * 32 : item * 128, T = sample ? 32 : 128, tseq0 = sample ? 0 : (item & 31) * 128;
        for (int r0 = wave; r0 < T; r0 += 32) {
            u32x4 wv[4][2];
#pragma unroll
            for (int q = 0; q < 4; ++q) { const int r = r0 + 8 * q; if (r < T) { const bf16_t* vp = Z + (size_t)(row0 + r) * NZ + 1536 + lane * 8; wv[q][0] = *(const u32x4*)vp; wv[q][1] = *(const u32x4*)(vp + 512); } }
#pragma unroll
            for (int q = 0; q < 4; ++q) { const int r = r0 + 8 * q; if (r < T) {
                float x[16]; { float f[8]; unpack8(wv[q][0], f);
#pragma unroll
                    for (int k = 0; k < 8; ++k) x[k] = f[k];
                    unpack8(wv[q][1], f);
#pragma unroll
                    for (int k = 0; k < 8; ++k) x[8 + k] = f[k]; }
                float s = 0.f;
#pragma unroll
                for (int k = 0; k < 16; ++k) s += x[k];
                const float mean = wave_sum(s) * (1.0f / 1024.0f); float q2 = 0.f;
#pragma unroll
                for (int k = 0; k < 16; ++k) { x[k] -= mean; q2 += x[k] * x[k]; }
                const float rstd = rsqrtf(wave_sum(q2) * (1.0f / 1024.0f) + LN_EPS);
                if (lane == 0) stats[r] = (f32x2){mean, rstd};
                if (sample) {
                    float* o = out + O_SGV + ((size_t)(l * 16 + sb) * 32 + r) * 1024;
#pragma unroll
                    for (int h = 0; h < 2; ++h) { const int c = h * 512 + lane * 8; const float* gp = a.in[I_SLNG] + l * 1024 + c; const float* bp = a.in[I_SLNB] + l * 1024 + c;
                        const f32x4 g0 = *(const f32x4*)gp, g1 = *(const f32x4*)(gp + 4), b0 = *(const f32x4*)bp, b1 = *(const f32x4*)(bp + 4);
                        f32x4 y0, y1;
#pragma unroll
                        for (int k = 0; k < 4; ++k) { y0[k] = x[h * 8 + k] * rstd * g0[k] + b0[k]; y1[k] = x[h * 8 + 4 + k] * rstd * g1[k] + b1[k]; }
                        *(f32x4*)(o + c) = y0; *(f32x4*)(o + c + 4) = y1; }
                }
            } }
        }
        __syncthreads();
        {
        int tidB = tid; asm volatile("" : "+v"(tidB)); const int l15b = tidB & 15, quadb = (tidB >> 4) & 3;
        const unsigned offV = 2u * (unsigned)(quadb * 8 * NZ + 4 * l15b), offW = 2u * (unsigned)(l15b * 128 + quadb * 8), offU = 2u * (unsigned)(l15b * NZ + 16 * quadb), offY = 2u * (unsigned)(l15b * DM + 16 * quadb);
#pragma unroll 1
        for (int hb = 0; hb < 2; ++hb) {
            const int cbase = g * 128 + hb * 64;
            u32x2 xr[4][8];
#pragma unroll
            for (int kb = 0; kb < 4; ++kb) if (kb * 32 < T) {
#pragma unroll
                for (int j = 0; j < 8; ++j) xr[kb][j] = *(const u32x2*)(uptr(Z + (size_t)(row0 + kb * 32 + j) * NZ + 1536 + cbase) + offV); }
            const f32x4 gam4 = *(const f32x4*)(uptr(a.in[I_SLNG] + l * 1024 + cbase) + 16u * (unsigned)l15b), bet4 = *(const f32x4*)(uptr(a.in[I_SLNB] + l * 1024 + cbase) + 16u * (unsigned)l15b);
            bf16x8 Vf[4][4];
#pragma unroll
            for (int kb = 0; kb < 4; ++kb) {
                if (kb * 32 < T) {
                    float vn[4][8];
#pragma unroll
                    for (int j = 0; j < 8; ++j) { const f32x2 st = stats[kb * 32 + quadb * 8 + j];
                        vn[0][j] = (bflo(xr[kb][j].x) - st.x) * st.y * gam4[0] + bet4[0]; vn[1][j] = (bfhi(xr[kb][j].x) - st.x) * st.y * gam4[1] + bet4[1];
                        vn[2][j] = (bflo(xr[kb][j].y) - st.x) * st.y * gam4[2] + bet4[2]; vn[3][j] = (bfhi(xr[kb][j].y) - st.x) * st.y * gam4[3] + bet4[3]; }
#pragma unroll
                    for (int q = 0; q < 4; ++q) { u32x4 pk; pk.x = cvt_pk_bf16(vn[q][0], vn[q][1]); pk.y = cvt_pk_bf16(vn[q][2], vn[q][3]); pk.z = cvt_pk_bf16(vn[q][4], vn[q][5]); pk.w = cvt_pk_bf16(vn[q][6], vn[q][7]);
                        Vf[q][kb] = __builtin_bit_cast(bf16x8, pk); }
                } else {
#pragma unroll
                    for (int q = 0; q < 4; ++q) Vf[q][kb] = (bf16x8){0, 0, 0, 0, 0, 0, 0, 0}; }
            }
#pragma unroll
            for (int tb = 0; tb < 8; ++tb) {
                if (tb * 16 < T) {
                    bf16x8 wf[4];
#pragma unroll
                    for (int kb = 0; kb <= (tb >> 1); ++kb) wf[kb] = *(const bf16x8*)(uptr(sguw + (size_t)(g * 128 + tb * 16) * 128 + kb * 32) + offW);
                    const char* up = uptr(Z + (size_t)(row0 + tb * 16) * NZ + 512 + cbase) + offU;
                    const u32x4 u0 = *(const u32x4*)up, u1 = *(const u32x4*)(up + 16);
                    const float bias = *(const float*)(uptr(a.in[I_SGUB] + (l * 8 + g) * 128 + tb * 16) + 4u * (unsigned)l15b);
                    f32x4 acc[4];
#pragma unroll
                    for (int q = 0; q < 4; ++q) { acc[q] = (f32x4){0.f, 0.f, 0.f, 0.f};
#pragma unroll
                        for (int kb = 0; kb <= (tb >> 1); ++kb) acc[q] = __builtin_amdgcn_mfma_f32_16x16x32_bf16(Vf[q][kb], wf[kb], acc[q], 0, 0, 0); }
                    float uf[16]; { float f[8]; unpack8(u0, f);
#pragma unroll
                        for (int k = 0; k < 8; ++k) uf[k] = f[k];
                        unpack8(u1, f);
#pragma unroll
                        for (int k = 0; k < 8; ++k) uf[8 + k] = f[k]; }
                    float yo[16];
#pragma unroll
                    for (int jj = 0; jj < 4; ++jj)
#pragma unroll
                        for (int q = 0; q < 4; ++q) yo[4 * jj + q] = uf[4 * jj + q] * (acc[q][jj] + bias);
                    char* yp = uptr(Y + (size_t)(row0 + tb * 16) * DM + 512 + cbase) + offY;
                    *(u32x4*)yp = pg8::pack8((f32x4){yo[0], yo[1], yo[2], yo[3]}, (f32x4){yo[4], yo[5], yo[6], yo[7]});
                    *(u32x4*)(yp + 16) = pg8::pack8((f32x4){yo[8], yo[9], yo[10], yo[11]}, (f32x4){yo[12], yo[13], yo[14], yo[15]});
                }
            }
        }
        }
        asm volatile("" ::: "memory");
        {
            const int cg8 = (tid & 63) * 8, rseg = tid >> 6, rl = T >> 3, rb = rseg * rl;
            {
                const int win = 2 << ((tid & 63) >> 4);
                float S[8];
#pragma unroll
                for (int j = 0; j < 8; ++j) S[j] = 0.f;
                for (int r = rb - (win - 1); r < rb + rl; ++r) {
                    float av[8]; const int tabs = tseq0 + r;
                    if (tabs >= 0) { const u32x4 w = *(const u32x4*)(Z + (size_t)(row0 + r) * NZ + cg8); unpack8(w, av); }
                    else if (sample) { const float* hp = a.in[I_SPOOL] + ((size_t)(l * 16 + sb) * 15 + (15 + tabs)) * 512 + cg8; const f32x4 h0 = *(const f32x4*)hp, h1 = *(const f32x4*)(hp + 4);
#pragma unroll
                        for (int j = 0; j < 4; ++j) { av[j] = h0[j]; av[4 + j] = h1[j]; } }
                    else {
#pragma unroll
                        for (int j = 0; j < 8; ++j) av[j] = 0.f; }
#pragma unroll
                    for (int j = 0; j < 8; ++j) S[j] += av[j];
                    if (r >= rb) {
                        const int cnt = sample ? win : min(tabs + 1, win); const float inv = 1.0f / (float)cnt;
                        f32x4 p0, p1;
#pragma unroll
                        for (int j = 0; j < 4; ++j) { p0[j] = S[j] * inv - av[j]; p1[j] = S[4 + j] * inv - av[4 + j]; }
                        *(u32x4*)(Y + (size_t)(row0 + r) * DM + cg8) = pg8::pack8(p0, p1);
                        float* np = nullptr;
                        if (sample) { if (r >= 17) np = out + O_NPS + ((size_t)(l * 16 + sb) * 15 + (r - 17)) * 512 + cg8; }
                        else if (tabs >= 4096 - 15) np = out + O_NPP + ((size_t)(l * 8 + b) * 15 + (tabs - (4096 - 15))) * 512 + cg8;
                        if (np) { *(f32x4*)np = (f32x4){av[0], av[1], av[2], av[3]}; *(f32x4*)(np + 4) = (f32x4){av[4], av[5], av[6], av[7]}; }
                        const int rd = r - win + 1, td = tseq0 + rd; float dv[8];
                        if (td >= 0) { const u32x4 w = *(const u32x4*)(Z + (size_t)(row0 + rd) * NZ + cg8); unpack8(w, dv); }
                        else if (sample) { const float* hp = a.in[I_SPOOL] + ((size_t)(l * 16 + sb) * 15 + (15 + td)) * 512 + cg8; const f32x4 h0 = *(const f32x4*)hp, h1 = *(const f32x4*)(hp + 4);
#pragma unroll
                            for (int j = 0; j < 4; ++j) { dv[j] = h0[j]; dv[4 + j] = h1[j]; } }
                        else {
#pragma unroll
                            for (int j = 0; j < 8; ++j) dv[j] = 0.f; }
#pragma unroll
                        for (int j = 0; j < 8; ++j) S[j] -= dv[j];
                    }
                }
            }
            {
                const float* cw = a.in[I_CONVW] + (size_t)l * 3 * 512 + cg8;
                float w0[8], w1[8], w2[8], p2[8], p1[8];
#pragma unroll
                for (int j = 0; j < 8; ++j) { w0[j] = cw[j]; w1[j] = cw[512 + j]; w2[j] = cw[1024 + j]; p2[j] = 0.f; p1[j] = 0.f; }
                for (int r = rb - 2; r < rb + rl; ++r) {
                    float ci[8]; const int tabs = tseq0 + r;
                    if (tabs >= 0) { const bf16_t* zp = Z + (size_t)(row0 + r) * NZ + cg8; const u32x4 wc_ = *(const u32x4*)(zp + 3072), wx = *(const u32x4*)(zp + 3584); float fc[8], fx[8]; unpack8(wc_, fc); unpack8(wx, fx);
#pragma unroll
                        for (int j = 0; j < 8; ++j) ci[j] = fc[j] * fx[j]; }
                    else if (sample) { const float* hp = a.in[I_SCONV] + ((size_t)(l * 16 + sb) * 2 + (2 + tabs)) * 512 + cg8; const f32x4 h0 = *(const f32x4*)hp, h1 = *(const f32x4*)(hp + 4);
#pragma unroll
                        for (int j = 0; j < 4; ++j) { ci[j] = h0[j]; ci[4 + j] = h1[j]; } }
                    else {
#pragma unroll
                        for (int j = 0; j < 8; ++j) ci[j] = 0.f; }
                    if (r >= rb) {
                        const u32x4 wb = *(const u32x4*)(Z + (size_t)(row0 + r) * NZ + 2560 + cg8); float fb[8]; unpack8(wb, fb);
                        f32x4 y0, y1;
#pragma unroll
                        for (int j = 0; j < 4; ++j) { y0[j] = fb[j] * (w0[j] * p2[j] + w1[j] * p1[j] + w2[j] * ci[j]); y1[j] = fb[4 + j] * (w0[4 + j] * p2[4 + j] + w1[4 + j] * p1[4 + j] + w2[4 + j] * ci[4 + j]); }
                        *(u32x4*)(Y + (size_t)(row0 + r) * DM + 1536 + cg8) = pg8::pack8(y0, y1);
                        float* np = nullptr;
                        if (sample) { if (r >= 30) np = out + O_NCS + ((size_t)(l * 16 + sb) * 2 + (r - 30)) * 512 + cg8; }
                        else if (tabs >= 4094) np = out + O_NCP + ((size_t)(l * 8 + b) * 2 + (tabs - 4094)) * 512 + cg8;
                        if (np) { *(f32x4*)np = (f32x4){ci[0], ci[1], ci[2], ci[3]}; *(f32x4*)(np + 4) = (f32x4){ci[4], ci[5], ci[6], ci[7]}; }
                    }
#pragma unroll
                    for (int j = 0; j < 8; ++j) { p2[j] = p1[j]; p1[j] = ci[j]; }
                }
            }
        }
        __syncthreads();
    }
}

__global__ void __launch_bounds__(512, 2) fwd_megakernel(Args a) {
    extern __shared__ __attribute__((aligned(16))) unsigned char lds_raw[];
    LAS unsigned char* lds = (LAS unsigned char*)lds_raw;
    cg::grid_group grid = cg::this_grid();
    const int G = gridDim.x, NGW = G * 8, NT = G * 512;
#define FRESH_IDS() int tid = threadIdx.x; asm volatile("" : "+v"(tid)); int bid = blockIdx.x; asm volatile("" : "+s"(bid)); \
    const int lane = tid & 63, wave = __builtin_amdgcn_readfirstlane(tid >> 6), gw = bid * 8 + wave, gtid = bid * 512 + tid; (void)lane; (void)gw; (void)gtid
    unsigned char* ws = a.ws;
    if (threadIdx.x < 4) ((volatile LAS unsigned*)(lds + 131072 + 64))[threadIdx.x] = 0u;
    __syncthreads();
    XcdBarrier xbar = xcd_barrier_post((unsigned*)ws, (volatile LAS unsigned*)(lds + 131072 + 64));
    grid.sync();
    bf16_t* XB = (bf16_t*)((unsigned char*)a.out + DO_XB); bf16_t* MG = (bf16_t*)((unsigned char*)a.out + DO_MG);
    bf16_t* Zb = (bf16_t*)(ws + WS_Z); bf16_t* Gb = (bf16_t*)(ws + WS_G); bf16_t* Yb = (bf16_t*)(ws + WS_Y);
    bf16_t* Tb = (bf16_t*)(ws + WS_T); bf16_t* X1 = (bf16_t*)(ws + WS_X1); bf16_t* ACT = (bf16_t*)(ws + WS_ACT); bf16_t* PE = (bf16_t*)(ws + WS_PE);
#ifndef PHMASK
#define PHMASK 0xffff
#endif
#define PH_ON(i) (((PHMASK) >> (i)) & 1)
#ifndef REPNG_MASK
#define REPNG_MASK 0
#endif
#define NREPNG(i) ((((REPNG_MASK) >> (i)) & 1) ? 2 : 1)
#ifndef REPG_MASK
#define REPG_MASK 0
#endif
#define NREPG(i) ((((REPG_MASK) >> (i)) & 1) ? 2 : 1)
#define RUN(k) (a.ph_lo <= (k) && (k) < a.ph_hi)
#define SEAM(k) do { if (RUN(k) && RUN((k) + 1)) xcd_barrier(xbar); } while (0)
#define SEAM_NOW() xcd_barrier(xbar)

    for (int rep = 0; rep < NREPNG(0); ++rep) if (RUN(0) && PH_ON(0)) {
        if (rep) SEAM_NOW();
        FRESH_IDS();
        convert_weights(a, 0, lds, gw, NGW, wave, lane);
        convert_rows(a.in[I_XP], (size_t)MP * DM / 8, a.in[I_XS], (size_t)MT * DM / 8, XB, gtid, NT);
        convert_rows(a.in[I_PP], (size_t)MP * PLE / 8, a.in[I_PS], (size_t)MT * PLE / 8, (bf16_t*)(ws + WS_PB0), gtid, NT);
        convert_rows(a.in[I_PP] + (size_t)MP * PLE, (size_t)MP * PLE / 8, a.in[I_PS] + (size_t)MS * PLE, (size_t)MT * PLE / 8, (bf16_t*)(ws + WS_PB1), gtid, NT);
    }
    SEAM(0);
    for (int l = 0; l < 2; ++l) {
        const int pb = 1 + 8 * l;
        for (int rep = 0; rep < NREPG(1); ++rep) if (RUN(pb + 0) && PH_ON(1)) {
            if (rep) SEAM_NOW();
            FRESH_IDS(); pg8::Gemm g{XB, (const bf16_t*)(ws + WS_WIN), DM, 1, pg8::pack3(DM / 64, 0, 0), 0u, 0}; pg8::Order S; S.init(MT / 256, NIN / 256, G, bid, 1);
            pg8::EpiIn E{Zb, Gb};
            pg8::gemm_phase<pg8::EpiIn, true, true>(lds, g, S, E, tid);
        }
        SEAM(pb + 0);
        for (int rep = 0; rep < NREPNG(1); ++rep) if (RUN(pb + 1) && PH_ON(2)) { if (rep) SEAM_NOW(); FRESH_IDS(); mix_phase(a, l, lds, Zb, Yb, tid, bid); }
        SEAM(pb + 1);
        for (int rep = 0; rep < NREPG(3); ++rep) if (RUN(pb + 2) && PH_ON(3)) {
            if (rep) SEAM_NOW();
            FRESH_IDS(); pg8::Gemm g{Yb, (const bf16_t*)(ws + WS_WBR), DM, 3, pg8::pack3(8, 16, 8), pg8::pack3(0, 8, 24), 0}; pg8::Order S; S.init(MT / 256, DM / 256, G, bid, 3);
            pg8::EpiBr E{Gb, MG};
            pg8::gemm_phase<pg8::EpiBr, true, true>(lds, g, S, E, tid);
        }
        SEAM(pb + 2);
        if (RUN(pb + 3)) {
            if (PH_ON(4)) { FRESH_IDS(); pg8::Gemm g{MG, (const bf16_t*)(ws + WS_WO), DM, 1, pg8::pack3(DM / 64, 0, 0), 0u, 0}; pg8::Order S; S.init(MP / 256, DM / 256, G, bid, 1); S.slices(MP / 256, MS / 256, 8); g.nts = 4;
              pg8::EpiRes E{XB, nullptr, Tb, (bf16_t*)(ws + WS_PART)};
              pg8::gemm_phase<pg8::EpiRes, true, true>(lds, g, S, E, tid); }
            if (PH_ON(5)) { FRESH_IDS(); pg8::Gemm g{(const bf16_t*)(ws + (l ? WS_PB1 : WS_PB0)), (const bf16_t*)(ws + WS_WPE), PLE, 1, pg8::pack3(PLE / 64, 0, 0), 0u, 0}; pg8::Order S; S.init(MT / 256, DM / 256, G, G - 1 - bid, 1);
              pg8::EpiStore E{PE, DM};
              pg8::gemm_phase<pg8::EpiStore, true, true>(lds, g, S, E, tid); }
        }
        SEAM(pb + 3);
        for (int rep = 0; rep < NREPNG(2); ++rep) if (RUN(pb + 4) && PH_ON(6)) { if (rep) SEAM_NOW(); FRESH_IDS(); ln_phase(Tb, XB, nullptr, (const bf16_t*)(ws + WS_PART), 8, a.in[I_LN1G] + l * DM, a.in[I_LN1B] + l * DM, X1, nullptr, gw, NGW, lane); }
        SEAM(pb + 4);
        if (RUN(pb + 5) && PH_ON(7)) {
            FRESH_IDS(); pg8::Gemm g{X1, (const bf16_t*)(ws + WS_WGU), DM, 1, pg8::pack3(DM / 64, 0, 0), 0u, 0}; pg8::Order S; S.init(MT / 256, NGU / 256, G, bid, 1);
            pg8::EpiGu E{ACT, PE};
            pg8::gemm_phase<pg8::EpiGu, true, true>(lds, g, S, E, tid);
        }
        SEAM(pb + 5);
        for (int rep = 0; rep < NREPG(8); ++rep) if (RUN(pb + 6) && PH_ON(8)) {
            if (rep) SEAM_NOW();
            FRESH_IDS(); pg8::Gemm g{ACT, (const bf16_t*)(ws + WS_WDN), LD_ACT, 1, pg8::pack3(DFF / 64, 0, 0), 0u, 0}; pg8::Order S; S.init(MP / 256, DM / 256, G, bid, 1); S.slices(MP / 256, MS / 256, 11); g.nts = 8;
            pg8::EpiRes E{X1, PE, Tb, (bf16_t*)(ws + WS_PART)};
            pg8::gemm_phase<pg8::EpiRes, true, true>(lds, g, S, E, tid);
        }
        SEAM(pb + 6);
        for (int rep = 0; rep < NREPNG(3); ++rep) if (RUN(pb + 7) && PH_ON(9)) {
            if (rep) SEAM_NOW();
            FRESH_IDS();
            if (l == 0) { ln_phase(Tb, X1, PE, (const bf16_t*)(ws + WS_PART), 11, a.in[I_LN2G], a.in[I_LN2B], XB, nullptr, gw, NGW, lane); convert_weights(a, 1, lds, gw, NGW, wave, lane); }
            else ln_phase(Tb, X1, PE, (const bf16_t*)(ws + WS_PART), 11, a.in[I_LN2G] + DM, a.in[I_LN2B] + DM, nullptr, a.out, gw, NGW, lane);
        }
        if (l == 0) SEAM(pb + 7);
    }
#undef RUN
#undef SEAM
}

extern "C" void kernel_launch(void* const* d_in, const int* in_sizes, int n_in, void* d_out, int out_size, void* d_ws, size_t ws_size, hipStream_t stream) {
    static int grid = 0;
    if (grid == 0) {
        if (n_in != 26 || ws_size < WS_END) { fprintf(stderr, "kernel_launch: expected 26 inputs and >= %zu bytes of workspace (got %d, %zu)\n", (size_t)WS_END, n_in, ws_size); grid = -1; return; }
        int dev = 0, cus = 0, per_cu = 0;
        (void)hipGetDevice(&dev); (void)hipDeviceGetAttribute(&cus, hipDeviceAttributeMultiprocessorCount, dev);
        if (hipFuncSetAttribute((const void*)fwd_megakernel, hipFuncAttributeMaxDynamicSharedMemorySize, LDS_BYTES) != hipSuccess) { fprintf(stderr, "kernel_launch: hipFuncSetAttribute failed\n"); grid = -1; return; }
        if (hipOccupancyMaxActiveBlocksPerMultiprocessor(&per_cu, (const void*)fwd_megakernel, 512, LDS_BYTES) != hipSuccess || per_cu < 1) { fprintf(stderr, "kernel_launch: occupancy query says %d blocks/CU\n", per_cu); per_cu = 1; }
        (void)hipGetLastError();
        grid = cus;
    }
    if (grid < 0) return;
    if (hipMemsetAsync(d_ws, 0, 16384, stream) != hipSuccess) { fprintf(stderr, "kernel_launch: hipMemsetAsync failed\n"); return; }
    Args a{};
    for (int i = 0; i < 26; ++i) a.in[i] = (const float*)d_in[i];
    a.out = (float*)d_out; a.ws = (unsigned char*)d_ws; a.ph_lo = 0; a.ph_hi = 17;
    void* args[] = {&a};
    hipError_t e = hipLaunchCooperativeKernel((const void*)fwd_megakernel, dim3(grid), dim3(512), args, LDS_BYTES, stream);
    if (e != hipSuccess) fprintf(stderr, "kernel_launch: cooperative launch failed: %s (grid %d)\n", hipGetErrorString(e), grid);
}
```
